# Optimizing an MI355X kernel written in HIP

```python
import math
import jax, jax.numpy as jnp
from jax import lax
import numpy as np

D_MODEL = 1024
BATCH = 8
SEQ = 2048
DEPTH = 1
DEC_BATCH = 32
DEC_SEQ = 1
PAST_LEN = 8192
PAGE_SIZE = 128

N_META = 16
ATTN_WIDTH = D_MODEL // 2
CONV_DIM = D_MODEL - ATTN_WIDTH
N_DIFF_HEADS = 4
HEAD_DIM = ATTN_WIDTH // N_DIFF_HEADS // 2
V_HEAD_DIM = 2 * HEAD_DIM
CONV_WIDTH = 31
FFN_HIDDEN = -(-8 * D_MODEL // (3 * 256)) * 256
IN_COLS = 3 * ATTN_WIDTH + 2 * CONV_DIM
Q_BLOCK = 128
EPS = 1e-6
NEG_INF = -1e30

kernel_name = "hymba_diffattn_conformer_decoder_step"


def rms_norm(x, w):
    xf = x.astype(jnp.float32)
    y = xf * lax.rsqrt(jnp.mean(xf * xf, axis=-1, keepdims=True) + EPS)
    return (y * w.astype(jnp.float32)).astype(x.dtype)


def layer_norm(x, w, b):
    xf = x.astype(jnp.float32)
    mu = jnp.mean(xf, axis=-1, keepdims=True)
    xc = xf - mu
    y = xc * lax.rsqrt(jnp.mean(xc * xc, axis=-1, keepdims=True) + EPS)
    return (y * w.astype(jnp.float32) + b.astype(jnp.float32)).astype(x.dtype)


def alibi_slopes():
    h = jnp.arange(1, N_DIFF_HEADS + 1, dtype=jnp.float32)
    return jnp.exp2(-8.0 * h / N_DIFF_HEADS)


def lambda_init_of(li):
    return 0.8 - 0.6 * math.exp(-0.3 * li)


def diff_lambda(lw, li):
    f = jnp.float32
    return (jnp.exp(jnp.sum(lw['lq1'].astype(f) * lw['lk1'].astype(f)))
            - jnp.exp(jnp.sum(lw['lq2'].astype(f) * lw['lk2'].astype(f)))
            + lambda_init_of(li))


def split_proj(p):
    B, L, _ = p.shape
    q = p[..., :ATTN_WIDTH].reshape(B, L, N_DIFF_HEADS, 2, HEAD_DIM)
    k = p[..., ATTN_WIDTH:2 * ATTN_WIDTH].reshape(B, L, N_DIFF_HEADS, 2, HEAD_DIM)
    v = p[..., 2 * ATTN_WIDTH:3 * ATTN_WIDTH].reshape(B, L, N_DIFF_HEADS, V_HEAD_DIM)
    a = p[..., 3 * ATTN_WIDTH:3 * ATTN_WIDTH + CONV_DIM]
    g = p[..., 3 * ATTN_WIDTH + CONV_DIM:]
    u = a * jax.nn.sigmoid(g)
    return q, k, v, u


def diff_attend(q, k, v, q_pos, k_pos, lam, slopes):
    s = jnp.einsum('bqhjd,bkhjd->bhjqk', q, k,
                   preferred_element_type=jnp.float32) * (HEAD_DIM ** -0.5)
    dist = (q_pos[:, None] - k_pos[None, :]).astype(jnp.float32)
    s = s - slopes[None, :, None, None, None] * dist
    s = jnp.where((k_pos[None, :] <= q_pos[:, None])[None, None, None], s, NEG_INF)
    p = jax.nn.softmax(s, axis=-1)
    a = p[:, :, 0] - lam * p[:, :, 1]
    return jnp.einsum('bhqk,bkhe->bqhe', a.astype(v.dtype), v)


def diff_head_out(o, lw, li):
    o = rms_norm(o, lw['subln']) * (1.0 - lambda_init_of(li))
    return o.reshape(o.shape[:2] + (ATTN_WIDTH,))


def causal_depthwise(u_padded, w, b):
    y = lax.conv_general_dilated(u_padded, w[:, None, :].astype(u_padded.dtype),
                                 window_strides=(1,), padding='VALID',
                                 dimension_numbers=('NWC', 'WIO', 'NWC'),
                                 feature_group_count=CONV_DIM)
    return y + b


def finish_layer(x_res, attn_o, conv_y, lw, li):
    attn_out = diff_head_out(attn_o, lw, li)
    conv_out = jax.nn.silu(layer_norm(conv_y, lw['cln_w'], lw['cln_b']))
    mix = jnp.concatenate([attn_out, conv_out], axis=-1) @ lw['w_out']
    x = x_res + rms_norm(mix, lw['ln_mix_post'])
    h = rms_norm(x, lw['ln_ffn_pre'])
    f = (jax.nn.silu(h @ lw['w_gate']) * (h @ lw['w_up'])) @ lw['w_down']
    return x + rms_norm(f, lw['ln_ffn_post'])


def prompt_layer(x, lw, li, last):
    B, T, _ = x.shape
    n_real = T - N_META
    nb = n_real // Q_BLOCK
    proj = rms_norm(x, lw['ln_mix_pre']) @ lw['w_in']
    q, k, v, u = split_proj(proj)
    lam = diff_lambda(lw, li)
    slopes = alibi_slopes()
    k_pos = jnp.arange(T)
    q_blocks = q[:, N_META:].reshape(B, nb, Q_BLOCK, N_DIFF_HEADS, 2, HEAD_DIM).transpose(1, 0, 2, 3, 4, 5)
    qpos_blocks = (N_META + jnp.arange(n_real)).reshape(nb, Q_BLOCK)
    o_blocks = lax.map(lambda a: diff_attend(a[0], k, v, a[1], k_pos, lam, slopes),
                       (q_blocks, qpos_blocks))
    o = o_blocks.transpose(1, 0, 2, 3, 4).reshape(B, n_real, N_DIFF_HEADS, V_HEAD_DIM)
    r0 = N_META
    if not last:
        o_meta = diff_attend(q[:, :N_META], k[:, :N_META], v[:, :N_META],
                             k_pos[:N_META], k_pos[:N_META], lam, slopes)
        o = jnp.concatenate([o_meta, o], axis=1)
        r0 = 0
    u_pad = jnp.pad(u, ((0, 0), (CONV_WIDTH - 1, 0), (0, 0)))
    y = causal_depthwise(u_pad, lw['conv_w'], lw['conv_b'])
    x_out = finish_layer(x[:, r0:], o, y[:, r0:], lw, li)
    new_k = k.reshape(B, T, 2 * N_DIFF_HEADS, HEAD_DIM)
    new_conv = u[:, T - (CONV_WIDTH - 1):]
    return x_out, new_k, v, new_conv


def sample_layer(x, ck, cv, conv_state, page_table, lw, li):
    Bd, S, _ = x.shape
    past = page_table.shape[1] * PAGE_SIZE
    proj = rms_norm(x, lw['ln_mix_pre']) @ lw['w_in']
    q, k, v, u = split_proj(proj)
    lam = diff_lambda(lw, li)
    k_past = ck[page_table].reshape(Bd, past, N_DIFF_HEADS, 2, HEAD_DIM).astype(k.dtype)
    v_past = cv[page_table].reshape(Bd, past, N_DIFF_HEADS, V_HEAD_DIM).astype(v.dtype)
    k_all = jnp.concatenate([k_past, k], axis=1)
    v_all = jnp.concatenate([v_past, v], axis=1)
    k_pos = jnp.arange(past + S)
    q_pos = past + jnp.arange(S)
    o = diff_attend(q, k_all, v_all, q_pos, k_pos, lam, alibi_slopes())
    u_full = jnp.concatenate([conv_state.astype(u.dtype), u], axis=1)
    y = causal_depthwise(u_full, lw['conv_w'], lw['conv_b'])
    x_out = finish_layer(x, o, y, lw, li)
    new_k = k.reshape(Bd, S, 2 * N_DIFF_HEADS, HEAD_DIM)
    new_conv = u_full[:, S:]
    return x_out, new_k, v, new_conv


def setup_inputs(seed: int = 0) -> dict:
    key = jax.random.key(seed)
    ks = jax.random.split(key, 32)
    f = jnp.float32
    n_pages = PAST_LEN // PAGE_SIZE
    n_used = DEC_BATCH * n_pages
    n_pool = n_used + max(1, n_used // 4)
    page_table = jax.random.permutation(ks[0], n_pool)[:n_used].reshape(DEC_BATCH, n_pages).astype(jnp.int32)
    nrm = lambda i, shape, s: (jax.random.normal(ks[i], shape, f) * s).astype(f)
    gain = lambda i, shape: (1.0 + 0.05 * jax.random.normal(ks[i], shape, f)).astype(f)
    return {
        'x_prompt': nrm(1, (BATCH, SEQ, D_MODEL), 1.0),
        'x_sample': nrm(2, (DEC_BATCH, DEC_SEQ, D_MODEL), 1.0),
        'cache_k': nrm(3, (DEPTH, n_pool, PAGE_SIZE, 2 * N_DIFF_HEADS, HEAD_DIM), 1.0),
        'cache_v': nrm(4, (DEPTH, n_pool, PAGE_SIZE, N_DIFF_HEADS, V_HEAD_DIM), 1.0),
        'state_conv': nrm(5, (DEPTH, DEC_BATCH, CONV_WIDTH - 1, CONV_DIM), 0.5),
        'page_table': page_table,
        'meta_tokens': nrm(6, (N_META, D_MODEL), 1.0),
        'ln_mix_pre': gain(7, (DEPTH, D_MODEL)),
        'ln_mix_post': gain(8, (DEPTH, D_MODEL)),
        'w_in': nrm(9, (DEPTH, D_MODEL, IN_COLS), D_MODEL ** -0.5),
        'lambda_q1': nrm(10, (DEPTH, HEAD_DIM), 0.1),
        'lambda_k1': nrm(11, (DEPTH, HEAD_DIM), 0.1),
        'lambda_q2': nrm(12, (DEPTH, HEAD_DIM), 0.1),
        'lambda_k2': nrm(13, (DEPTH, HEAD_DIM), 0.1),
        'subln_w': gain(14, (DEPTH, V_HEAD_DIM)),
        'conv_w': nrm(15, (DEPTH, CONV_WIDTH, CONV_DIM), CONV_WIDTH ** -0.5),
        'conv_b': nrm(16, (DEPTH, CONV_DIM), 0.02),
        'conv_ln_w': gain(17, (DEPTH, CONV_DIM)),
        'conv_ln_b': nrm(18, (DEPTH, CONV_DIM), 0.02),
        'w_out': nrm(19, (DEPTH, D_MODEL, D_MODEL), D_MODEL ** -0.5),
        'ln_ffn_pre': gain(20, (DEPTH, D_MODEL)),
        'ln_ffn_post': gain(21, (DEPTH, D_MODEL)),
        'w_gate': nrm(22, (DEPTH, D_MODEL, FFN_HIDDEN), D_MODEL ** -0.5),
        'w_up': nrm(23, (DEPTH, D_MODEL, FFN_HIDDEN), D_MODEL ** -0.5),
        'w_down': nrm(24, (DEPTH, FFN_HIDDEN, D_MODEL), FFN_HIDDEN ** -0.5),
    }


def reference(x_prompt, x_sample, cache_k, cache_v, state_conv, page_table, meta_tokens,
              ln_mix_pre, ln_mix_post, w_in, lambda_q1, lambda_k1, lambda_q2, lambda_k2,
              subln_w, conv_w, conv_b, conv_ln_w, conv_ln_b, w_out, ln_ffn_pre, ln_ffn_post,
              w_gate, w_up, w_down):
    B = x_prompt.shape[0]
    meta = jnp.broadcast_to(meta_tokens[None].astype(x_prompt.dtype), (B, N_META, D_MODEL))
    xp = jnp.concatenate([meta, x_prompt], axis=1)
    xs = x_sample
    kp_l, vp_l, cp_l, ks_l, vs_l, cs_l = [], [], [], [], [], []
    for li in range(DEPTH):
        lw = dict(ln_mix_pre=ln_mix_pre[li], ln_mix_post=ln_mix_post[li], w_in=w_in[li],
                  lq1=lambda_q1[li], lk1=lambda_k1[li], lq2=lambda_q2[li], lk2=lambda_k2[li],
                  subln=subln_w[li], conv_w=conv_w[li], conv_b=conv_b[li],
                  cln_w=conv_ln_w[li], cln_b=conv_ln_b[li], w_out=w_out[li],
                  ln_ffn_pre=ln_ffn_pre[li], ln_ffn_post=ln_ffn_post[li],
                  w_gate=w_gate[li], w_up=w_up[li], w_down=w_down[li])
        last = li == DEPTH - 1
        xp, kp, vp, cp = prompt_layer(xp, lw, li, last)
        xs, ks_, vs_, cs_ = sample_layer(xs, cache_k[li], cache_v[li], state_conv[li], page_table, lw, li)
        kp_l.append(kp); vp_l.append(vp); cp_l.append(cp)
        ks_l.append(ks_); vs_l.append(vs_); cs_l.append(cs_)
    return (xp, xs, jnp.stack(kp_l), jnp.stack(vp_l), jnp.stack(cp_l),
            jnp.stack(ks_l), jnp.stack(vs_l), jnp.stack(cs_l))
```

```cpp
#include <hip/hip_runtime.h>
#include <cstdio>
#include <cstdint>

constexpr int D = 1024, NB = 8, SEQ = 2048, NMETA = 16, TT = NMETA + SEQ  , DB = 32, PAST = 8192, PAGE = 128, NPAGES = PAST / PAGE;
constexpr int NH = 4, HD = 64, DV = 128, AW = 512, CD = 512, CW = 31, FF = 2816, INC = 2560;
constexpr int M_REAL = NB * SEQ;
constexpr int ROW_META = M_REAL;
constexpr int ROW_DEC = M_REAL + NMETA;
constexpr int M_PAD = M_REAL + 256;
constexpr int KVROWS = 64 + SEQ;
constexpr int UROWS = 30 + TT;
constexpr float EPS = 1e-6f;
constexpr float LOG2E = 1.4426950408889634f;
constexpr float QSCALE = 0.125f * LOG2E;
constexpr float LAMBDA_INIT = 0.2f;

constexpr size_t O_YP = 0, O_YS = O_YP + (size_t)M_REAL * D, O_KP = O_YS + (size_t)DB * D, O_VP = O_KP + (size_t)NB * TT * 512,
                 O_CP = O_VP + (size_t)NB * TT * 512, O_KS = O_CP + (size_t)NB * 30 * 512, O_VS = O_KS + (size_t)DB * 512, O_CS = O_VS + (size_t)DB * 512,
                 O_END = O_CS + (size_t)DB * 30 * 512;
static_assert(O_END == 34365440, "d_out size");

namespace pg8 {
#define PG8_LAS __attribute__((address_space(3)))
typedef unsigned short bf16_t;
typedef short bf16x8 __attribute__((ext_vector_type(8)));
typedef float f32x4 __attribute__((ext_vector_type(4)));
typedef unsigned u32x4 __attribute__((ext_vector_type(4)));
constexpr int BM = 256, BK = 64, HALF = 128, HTB = HALF * BK * 2  , STAGE_BYTES = 8 * HTB, NXCD = 8, WGM = 8;

__host__ __device__ __forceinline__ int lds_byte(int r, int c) { const int st = (r >> 4) * 2 + (c >> 5), rr = r & 15, cc = c & 31, ob = rr * 64 + cc * 2; return st * 1024 + (ob ^ (((ob >> 9) & 1) << 5)); }
__host__ __device__ __forceinline__ void stage_rc(int b, int& R, int& C) { const int st = b / 1024, sb = b % 1024, swz = sb ^ (((sb >> 9) & 1) << 5); R = (st >> 1) * 16 + swz / 64; C = (st & 1) * 32 + (swz % 64) / 2; }
__host__ __device__ __forceinline__ int perm32(int rho) { const int n = rho >> 4, i = rho & 15; return 8 * (i >> 2) + 4 * n + (i & 3); }

struct Unit { int pm, pn; };
struct Gemm { const bf16_t* A; const bf16_t* Bt; int M, N, K; };

struct StaticOrder {
    int nM, nN, nwg, G, c;
    __host__ __device__ void init(int M, int N, int G_, int c_) { nM = M / BM; nN = N / BM; nwg = nM * nN; G = G_; c = c_; }
    __host__ __device__ bool next(int i, Unit& u) const {
        const long L = (long)i * G + c; if (L >= nwg) return false;
        int wgid = (int)L; { const int q = nwg / NXCD, r = nwg % NXCD, xcd = wgid % NXCD, off = wgid / NXCD; wgid = (xcd < r ? xcd * (q + 1) : r * (q + 1) + (xcd - r) * q) + off; }
        const int nig = WGM * nN, gid = wgid / nig, fm = gid * WGM, gsz = (nM - fm) < WGM ? (nM - fm) : WGM;
        u.pm = fm + ((wgid % nig) % gsz); u.pn = (wgid % nig) / gsz; return true;
    }
    __device__ __forceinline__ void a_ready(const Unit&) const {}
    __device__ __forceinline__ void done(const Unit&) const {}
};

__device__ __forceinline__ unsigned cvt_pk_bf16(float lo, float hi) { unsigned r; asm volatile("v_cvt_pk_bf16_f32 %0, %1, %2" : "=v"(r) : "v"(lo), "v"(hi)); return r; }
typedef float f32x2 __attribute__((ext_vector_type(2)));
__device__ __forceinline__ u32x4 pack8(const f32x4& v0, const f32x4& v1) { u32x4 w; w.x = cvt_pk_bf16(v0[0], v0[1]); w.y = cvt_pk_bf16(v0[2], v0[3]); w.z = cvt_pk_bf16(v1[0], v1[1]); w.w = cvt_pk_bf16(v1[2], v1[3]); return w; }
__device__ __forceinline__ float sigmoidf_(float x) { return __builtin_amdgcn_rcpf(1.0f + __builtin_amdgcn_exp2f(-LOG2E * x)); }

struct EpiIn {
    static constexpr bool PERM = true, AFTER_DRAIN = false;
    bf16_t *Qb, *Kb, *Vb, *Ub; float* out; float* dcq;
    __device__ __forceinline__ void operator()(const f32x4 (&acc)[2][2][4][2], const Unit& u, int wr, int wc, int fr, int fq) const {
        asm volatile("" : "+v"(fr), "+v"(fq));
        const int pn = u.pn, cin = wc * 32 + 8 * fq;
        if (pn < 6) {
            const int kind = pn >> 1;
#pragma unroll
            for (int ai = 0; ai < 2; ++ai)
#pragma unroll
                for (int m = 0; m < 4; ++m) {
                    const int lrb = ai * HALF + wr * 64 + m * 16;
                    const int row = u.pm * BM + lrb + fr;
#pragma unroll
                    for (int bj = 0; bj < 2; ++bj) {
                        const int cc = (pn & 1) * 256 + bj * HALF + cin;
                        f32x4 v0 = acc[ai][bj][m][0], v1 = acc[ai][bj][m][1];
                        if (kind == 0) { v0 = v0 * QSCALE; v1 = v1 * QSCALE; *(u32x4*)(Qb + (size_t)row * 512 + cc) = pack8(v0, v1);
                            if (u.pm == M_REAL / BM && lrb >= 16 && lrb < 48) { float* o = dcq + (size_t)(lrb - 16 + fr) * 512 + cc; *(f32x4*)o = v0; *(f32x4*)(o + 4) = v1; } }
                        else {
                            bf16_t* bb = kind == 1 ? Kb : Vb; float* ob = out + (kind == 1 ? O_KP : O_VP); float* os = out + (kind == 1 ? O_KS : O_VS);
                            const u32x4 w = pack8(v0, v1);
                            if (u.pm < M_REAL / BM) { const int b = row >> 11, s = row & 2047;
                                float* o = ob + ((size_t)b * TT + NMETA + s) * 512 + cc; *(f32x4*)o = v0; *(f32x4*)(o + 4) = v1;
                                *(u32x4*)(bb + ((size_t)b * KVROWS + 64 + s) * 512 + cc) = w;
                            } else if (lrb == 0) {
                                for (int b = 0; b < NB; ++b) { float* o = ob + ((size_t)b * TT + fr) * 512 + cc; *(f32x4*)o = v0; *(f32x4*)(o + 4) = v1;
                                    *(u32x4*)(bb + ((size_t)b * KVROWS + fr) * 512 + cc) = w; }
                            } else if (lrb < 48) {
                                float* o = os + (size_t)(lrb - 16 + fr) * 512 + cc; *(f32x4*)o = v0; *(f32x4*)(o + 4) = v1;
                            }
                        }
                    }
                }
        } else {
            const int ch = (pn - 6) * HALF + cin;
#pragma unroll
            for (int ai = 0; ai < 2; ++ai)
#pragma unroll
                for (int m = 0; m < 4; ++m) {
                    const int lrb = ai * HALF + wr * 64 + m * 16; const int row = u.pm * BM + lrb + fr;
                    const f32x4 a0 = acc[ai][0][m][0], a1 = acc[ai][0][m][1], g0 = acc[ai][1][m][0], g1 = acc[ai][1][m][1];
                    f32x4 u0, u1;
#pragma unroll
                    for (int i = 0; i < 4; ++i) { u0[i] = a0[i] * sigmoidf_(g0[i]); u1[i] = a1[i] * sigmoidf_(g1[i]); }
                    const u32x4 w = pack8(u0, u1);
                    if (u.pm < M_REAL / BM) { const int b = row >> 11, s = row & 2047;
                        *(u32x4*)(Ub + ((size_t)b * UROWS + 30 + NMETA + s) * 512 + ch) = w;
                        if (s >= SEQ - 30) { float* o = out + O_CP + ((size_t)b * 30 + (s - (SEQ - 30))) * 512 + ch; *(f32x4*)o = u0; *(f32x4*)(o + 4) = u1; }
                    } else if (lrb == 0) {
                        for (int b = 0; b < NB; ++b) *(u32x4*)(Ub + ((size_t)b * UROWS + 30 + fr) * 512 + ch) = w;
                    } else if (lrb < 48) {
                        float* o = out + O_CS + ((size_t)(lrb - 16 + fr) * 30 + 29) * 512 + ch; *(f32x4*)o = u0; *(f32x4*)(o + 4) = u1;
                    }
                }
        }
    }
};
struct EpiF32 {
    static constexpr bool PERM = true, AFTER_DRAIN = false;
    float* O; int ldc;
    __device__ __forceinline__ void operator()(const f32x4 (&acc)[2][2][4][2], const Unit& u, int wr, int wc, int fr, int fq) const {
#pragma unroll
        for (int ai = 0; ai < 2; ++ai)
#pragma unroll
            for (int m = 0; m < 4; ++m) { float* rowp = O + (size_t)(u.pm * BM + ai * HALF + wr * 64 + m * 16 + fr) * ldc + u.pn * BM + wc * 32 + 8 * fq;
#pragma unroll
                for (int bj = 0; bj < 2; ++bj) { *(f32x4*)(rowp + bj * HALF) = acc[ai][bj][m][0]; *(f32x4*)(rowp + bj * HALF + 4) = acc[ai][bj][m][1]; } }
    }
};
struct EpiSwiGLU {
    static constexpr bool PERM = true, AFTER_DRAIN = false;
    bf16_t* O;
    __device__ __forceinline__ void operator()(const f32x4 (&acc)[2][2][4][2], const Unit& u, int wr, int wc, int fr, int fq) const {
#pragma unroll
        for (int ai = 0; ai < 2; ++ai)
#pragma unroll
            for (int m = 0; m < 4; ++m) { bf16_t* rowp = O + (size_t)(u.pm * BM + ai * HALF + wr * 64 + m * 16 + fr) * FF + u.pn * HALF + wc * 32 + 8 * fq;
                const f32x4 g0 = acc[ai][0][m][0], g1 = acc[ai][0][m][1], p0 = acc[ai][1][m][0], p1 = acc[ai][1][m][1]; f32x4 r0, r1;
#pragma unroll
                for (int i = 0; i < 4; ++i) { r0[i] = g0[i] * sigmoidf_(g0[i]) * p0[i]; r1[i] = g1[i] * sigmoidf_(g1[i]) * p1[i]; }
                *(u32x4*)rowp = pack8(r0, r1); }
    }
};

template <class Epi, class Sched, bool ALIGN_EPI = false, bool SP2 = false>
__device__ __forceinline__ void gemm_phase(PG8_LAS unsigned char* lds, const Gemm g, const Sched& S, const Epi& E) {
    const int tid = threadIdx.x, wid = __builtin_amdgcn_readfirstlane(tid >> 6), lane = tid & 63, wr = wid >> 2, wc = wid & 3, fr = lane & 15, fq = lane >> 4;
    const int K = g.K, nt = K / BK;
    unsigned voffA[2], voffB[2];
#pragma unroll
    for (int i = 0; i < 2; ++i) { int R, C; stage_rc(tid * 16 + i * 8192, R, C); const int Rb = Epi::PERM ? ((R & ~31) + perm32(R & 31)) : R;
        voffA[i] = (unsigned)(R * K + C) * 2u; voffB[i] = (unsigned)(Rb * K + C) * 2u; }
    const size_t kstep = (size_t)(BK * 2);
    const size_t hstep = (size_t)HALF * K * 2;
    const size_t tstep = 2 * hstep;
    const unsigned ldsw = (unsigned)wid * 1024u;
    const int aoff = lds_byte(wr * 64 + fr, fq * 8), boff = lds_byte(wc * 32 + fr, fq * 8);
#define PG8_SA(b, h) (((b) * 2 + (h)) * HTB)
#define PG8_SB(b, h) ((4 + (b) * 2 + (h)) * HTB)
#define PG8_STAGE(bufoff, gbase, voff) do { _Pragma("unroll") for (int _i = 0; _i < 2; ++_i) \
        __builtin_amdgcn_global_load_lds((const unsigned*)((const char*)(gbase) + (voff)[_i]), (PG8_LAS unsigned*)(lds + (bufoff) + ldsw + _i * 8192), 16, 0, 0); } while (0)
#define PG8_LDA(dst, b, h) do { _Pragma("unroll") for (int m = 0; m < 4; ++m) _Pragma("unroll") for (int k = 0; k < 2; ++k) dst[m][k] = *(const PG8_LAS bf16x8*)(lds + PG8_SA(b, h) + aoff + m * 2048 + k * 1024); } while (0)
#define PG8_LDB(dst, b, h) do { _Pragma("unroll") for (int n = 0; n < 2; ++n) _Pragma("unroll") for (int k = 0; k < 2; ++k) dst[n][k] = *(const PG8_LAS bf16x8*)(lds + PG8_SB(b, h) + boff + n * 2048 + k * 1024); } while (0)
#define PG8_MMA(ai, bj, At, Bt) do { __builtin_amdgcn_s_setprio(1); _Pragma("unroll") for (int m = 0; m < 4; ++m) _Pragma("unroll") for (int n = 0; n < 2; ++n) _Pragma("unroll") for (int k = 0; k < 2; ++k) \
        acc[ai][bj][m][n] = __builtin_amdgcn_mfma_f32_16x16x32_bf16(Bt[n][k], At[m][k], acc[ai][bj][m][n], 0, 0, 0); __builtin_amdgcn_s_setprio(0); } while (0)
#define PG8_WAIT_V(n) asm volatile("s_waitcnt vmcnt(" #n ")" ::: "memory")
#define PG8_WAIT_L(n) asm volatile("s_waitcnt lgkmcnt(" #n ")" ::: "memory")
#define PG8_BAR __builtin_amdgcn_s_barrier()
#define PG8_SCHED __builtin_amdgcn_sched_barrier(0)
    Unit cur, nxt; int ui = 0;
    if (!S.next(0, cur)) return;
    f32x4 acc[2][2][4][2];
#pragma unroll
    for (int a = 0; a < 2; ++a)
#pragma unroll
        for (int b = 0; b < 2; ++b)
#pragma unroll
            for (int m = 0; m < 4; ++m)
#pragma unroll
                for (int n = 0; n < 2; ++n) acc[a][b][m][n] = (f32x4){0.f, 0.f, 0.f, 0.f};
    bf16x8 At[4][2], B0[2][2], B1[2][2];
    const char* cA = (const char*)g.A + (size_t)cur.pm * tstep; const char* cB = (const char*)g.Bt + (size_t)cur.pn * tstep;
    S.a_ready(cur);
    if constexpr (SP2) {
        PG8_STAGE(PG8_SB(0, 0), cB, voffB); PG8_STAGE(PG8_SB(0, 1), cB + hstep, voffB); PG8_STAGE(PG8_SA(0, 0), cA, voffA); PG8_STAGE(PG8_SA(0, 1), cA + hstep, voffA);
        if (wr == 1) PG8_BAR;
        PG8_WAIT_V(2); PG8_BAR;
        PG8_STAGE(PG8_SB(1, 0), cB + kstep, voffB); PG8_STAGE(PG8_SA(1, 0), cA + kstep, voffA); PG8_STAGE(PG8_SB(1, 1), cB + hstep + kstep, voffB);
        PG8_WAIT_V(6); PG8_BAR;
    } else {
        PG8_STAGE(PG8_SB(0, 0), cB, voffB); PG8_STAGE(PG8_SA(0, 0), cA, voffA); PG8_STAGE(PG8_SB(0, 1), cB + hstep, voffB); PG8_STAGE(PG8_SA(0, 1), cA + hstep, voffA);
        if (wr == 1) PG8_BAR;
        PG8_WAIT_V(4); PG8_BAR;
        PG8_STAGE(PG8_SB(1, 0), cB + kstep, voffB); PG8_STAGE(PG8_SA(1, 0), cA + kstep, voffA); PG8_STAGE(PG8_SB(1, 1), cB + hstep + kstep, voffB);
        PG8_WAIT_V(6); PG8_BAR;
    }
    for (;;) {
        const bool has_next = S.next(ui + 1, nxt);
        const char* nA = has_next ? (const char*)g.A + (size_t)nxt.pm * tstep : cA; const char* nB = has_next ? (const char*)g.Bt + (size_t)nxt.pn * tstep : cB;
        for (int t = 0; t < nt; t += 2) {
            const bool last = (t == nt - 2);
            const char* a1 = cA + (size_t)(t + 1) * kstep;
            const char* a2 = last ? nA : cA + (size_t)(t + 2) * kstep; const char* b2 = last ? nB : cB + (size_t)(t + 2) * kstep;
            const char* a3 = a2 + kstep; const char* b3 = b2 + kstep;
            if (last && has_next) S.a_ready(nxt);
            if constexpr (SP2) {
            PG8_LDB(B0, 0, 0); PG8_LDB(B1, 0, 1); PG8_SCHED; PG8_LDA(At, 0, 0); PG8_STAGE(PG8_SA(1, 1), a1 + hstep, voffA);
            PG8_WAIT_V(8); PG8_WAIT_L(0); PG8_BAR; PG8_MMA(0, 0, At, B0); PG8_MMA(0, 1, At, B1); PG8_BAR; PG8_SCHED;
            PG8_LDA(At, 0, 1); PG8_STAGE(PG8_SB(0, 0), b2, voffB); PG8_STAGE(PG8_SB(0, 1), b2 + hstep, voffB); PG8_STAGE(PG8_SA(0, 0), a2, voffA);
            PG8_WAIT_V(8); PG8_WAIT_L(0); PG8_BAR; PG8_MMA(1, 0, At, B0); PG8_MMA(1, 1, At, B1); PG8_BAR; PG8_SCHED;
            PG8_LDB(B0, 1, 0); PG8_LDB(B1, 1, 1); PG8_SCHED; PG8_LDA(At, 1, 0); PG8_STAGE(PG8_SA(0, 1), a2 + hstep, voffA);
            PG8_WAIT_V(8); PG8_WAIT_L(0); PG8_BAR; PG8_MMA(0, 0, At, B0); PG8_MMA(0, 1, At, B1); PG8_BAR; PG8_SCHED;
            PG8_LDA(At, 1, 1); PG8_STAGE(PG8_SB(1, 0), b3, voffB); PG8_STAGE(PG8_SB(1, 1), b3 + hstep, voffB); PG8_STAGE(PG8_SA(1, 0), a3, voffA);
            PG8_WAIT_V(8); PG8_WAIT_L(0); PG8_BAR; PG8_MMA(1, 0, At, B0); PG8_MMA(1, 1, At, B1); PG8_BAR; PG8_SCHED;
            } else {
            PG8_LDB(B0, 0, 0); PG8_SCHED; PG8_LDA(At, 0, 0); PG8_STAGE(PG8_SA(1, 1), a1 + hstep, voffA);
            PG8_WAIT_L(8); PG8_BAR; PG8_WAIT_L(0); PG8_MMA(0, 0, At, B0); PG8_BAR; PG8_SCHED;
            PG8_LDB(B1, 0, 1); PG8_STAGE(PG8_SB(0, 0), b2, voffB);
            PG8_BAR; PG8_WAIT_L(0); PG8_MMA(0, 1, At, B1); PG8_BAR;
            PG8_LDA(At, 0, 1); PG8_STAGE(PG8_SA(0, 0), a2, voffA);
            PG8_BAR; PG8_WAIT_L(0); PG8_MMA(1, 0, At, B0); PG8_BAR; PG8_SCHED;
            PG8_STAGE(PG8_SB(0, 1), b2 + hstep, voffB);
            PG8_WAIT_V(6); PG8_BAR; PG8_MMA(1, 1, At, B1); PG8_BAR;
            PG8_LDB(B0, 1, 0); PG8_SCHED; PG8_LDA(At, 1, 0); PG8_STAGE(PG8_SA(0, 1), a2 + hstep, voffA);
            PG8_WAIT_L(8); PG8_BAR; PG8_WAIT_L(0); PG8_MMA(0, 0, At, B0); PG8_BAR; PG8_SCHED;
            PG8_LDB(B1, 1, 1); PG8_STAGE(PG8_SB(1, 0), b3, voffB);
            PG8_BAR; PG8_WAIT_L(0); PG8_MMA(0, 1, At, B1); PG8_BAR;
            PG8_LDA(At, 1, 1); PG8_STAGE(PG8_SA(1, 0), a3, voffA);
            PG8_BAR; PG8_WAIT_L(0); PG8_MMA(1, 0, At, B0); PG8_BAR; PG8_SCHED;
            PG8_STAGE(PG8_SB(1, 1), b3 + hstep, voffB);
            PG8_WAIT_V(6); PG8_BAR; PG8_MMA(1, 1, At, B1); PG8_BAR;
            }
        }
        if constexpr (ALIGN_EPI) { if (wr == 0) PG8_BAR; }
        if constexpr (!Epi::AFTER_DRAIN) { E(acc, cur, wr, wc, fr, fq); S.done(cur); }
        if (!has_next) break;
#pragma unroll
        for (int a = 0; a < 2; ++a)
#pragma unroll
            for (int b = 0; b < 2; ++b)
#pragma unroll
                for (int m = 0; m < 4; ++m)
#pragma unroll
                    for (int n = 0; n < 2; ++n) acc[a][b][m][n] = (f32x4){0.f, 0.f, 0.f, 0.f};
        cur = nxt; cA = nA; cB = nB; ++ui;
        if constexpr (ALIGN_EPI) { if (wr == 1) PG8_BAR; }
    }
    PG8_WAIT_V(0);
    if constexpr (!ALIGN_EPI) { if (wr == 0) PG8_BAR; }
    PG8_BAR;
    if constexpr (Epi::AFTER_DRAIN) { E.fused(acc, cur, wr, wc, fr, fq, lds, wid, lane); S.done(cur); }
#undef PG8_SA
#undef PG8_SB
#undef PG8_STAGE
#undef PG8_LDA
#undef PG8_LDB
#undef PG8_MMA
#undef PG8_WAIT_V
#undef PG8_WAIT_L
#undef PG8_BAR
#undef PG8_SCHED
}
}

constexpr size_t MiB = 1u << 20;
constexpr size_t WS_CTL = 0, CTL_ZERO_BYTES = 1 * MiB;
constexpr size_t WS_WIN = 2 * MiB;
constexpr size_t WS_WO = 8 * MiB;
constexpr size_t WS_WGU = 10 * MiB;
constexpr size_t WS_WD = 22 * MiB;
constexpr size_t WS_XN = 32 * MiB;
constexpr size_t WS_Q = 66 * MiB;
constexpr size_t WS_K = 84 * MiB;
constexpr size_t WS_V = 101 * MiB;
constexpr size_t WS_U = 118 * MiB;
constexpr size_t WS_MIX = 136 * MiB;
constexpr size_t WS_MIXOUT = 168 * MiB;
constexpr size_t WS_X1 = 232 * MiB;
constexpr size_t WS_HN = 296 * MiB;
constexpr size_t WS_ACT = 328 * MiB;
constexpr size_t WS_DEC = 416 * MiB;
constexpr size_t WS_END = 424 * MiB;
static_assert(WS_XN + (size_t)M_PAD * D * 2 <= WS_Q && WS_Q + (size_t)M_PAD * 512 * 2 <= WS_K && WS_K + (size_t)NB * KVROWS * 512 * 2 <= WS_V && WS_V + (size_t)NB * KVROWS * 512 * 2 <= WS_U &&
              WS_U + (size_t)NB * UROWS * 512 * 2 <= WS_MIX && WS_ACT + (size_t)M_REAL * FF * 2 <= WS_DEC, "d_ws map");
constexpr int NSPLIT = 8;
constexpr size_t DC_PART = 0;
constexpr size_t DC_MIX = DC_PART + (size_t)DB * NSPLIT * 8 * 132;
constexpr size_t DC_MIXOUT = DC_MIX + (size_t)DB * D;
constexpr size_t DC_X1 = DC_MIXOUT + (size_t)DB * D;
constexpr size_t DC_H = DC_X1 + (size_t)DB * D;
constexpr size_t DC_ACT = DC_H + (size_t)DB * D;
constexpr size_t DC_F = DC_ACT + (size_t)DB * FF;
constexpr size_t DC_Q = DC_F + (size_t)DB * D;
constexpr size_t DC_END = DC_Q + (size_t)DB * 512;
static_assert(DC_END * 4 <= 8 * MiB, "decode scratch");
constexpr int CW_TMO = 0, CW_CODE = 1;
constexpr int CW_BAR = 4096;

constexpr int NWAVES = 8;
constexpr int RING_OFF = 0, RING_BYTES = 131072;
constexpr int LDSCTL_OFF = RING_BYTES, MISC_OFF = LDSCTL_OFF + 320;
constexpr int LDS_BYTES = 147456;

#define GAS __attribute__((address_space(1)))
#define LAS __attribute__((address_space(3)))
typedef unsigned short bf16;
typedef unsigned v4u __attribute__((ext_vector_type(4)));
typedef float f32x4 __attribute__((ext_vector_type(4)));
typedef short bf16x8 __attribute__((ext_vector_type(8)));
typedef GAS unsigned gu32;
typedef GAS unsigned long long gu64;
#define RLX_AGENT __ATOMIC_RELAXED, __HIP_MEMORY_SCOPE_AGENT
#define LDS_WAIT() asm volatile("s_waitcnt lgkmcnt(0)" ::: "memory")
#define VM_WAIT() asm volatile("s_waitcnt vmcnt(0)" ::: "memory")
__device__ __forceinline__ unsigned long long rt() { return __builtin_amdgcn_s_memrealtime(); }
__device__ __forceinline__ unsigned f2bf(float f) { unsigned u = __builtin_bit_cast(unsigned, f); return (u + 0x7fffu + ((u >> 16) & 1u)) >> 16; }
__device__ __forceinline__ unsigned pk2(float lo, float hi) { return f2bf(lo) | (f2bf(hi) << 16); }

#define XB_TMO      128
#define XB_XCNT(j)  (256  + 64 * (j))
#define XB_XSUB(j)  (1280 + 64 * (j))
#define XB_XGEN(j)  (2304 + 64 * (j))
#define XB_TOP      3328
#define XB_TOPGEN   3392
#define XCD_BAR_WORDS 3456
#define XB_SPIN_CAP (1u << 18)

__device__ __forceinline__ unsigned xb_ld(unsigned* p)              { return __hip_atomic_load(p, __ATOMIC_RELAXED, __HIP_MEMORY_SCOPE_AGENT); }
__device__ __forceinline__ unsigned xb_add(unsigned* p, unsigned v) { return __hip_atomic_fetch_add(p, v, __ATOMIC_RELAXED, __HIP_MEMORY_SCOPE_AGENT); }
__device__ __forceinline__ unsigned xb_xcc_id() { return (unsigned)__builtin_amdgcn_s_getreg((3 << 11) | 20) & 0xFu; }
#define XB_SPIN(cond, bar) do { unsigned _sp = 0; while (cond) { __builtin_amdgcn_s_sleep(1); \
    if ((++_sp & 255u) == 0u) { if (xb_ld(&(bar)[XB_TMO])) break; if (_sp > XB_SPIN_CAP) { atomicAdd(&(bar)[XB_TMO], 1u); break; } } } } while (0)

struct XcdBarrier {
    unsigned* bar; unsigned x;
    volatile LAS unsigned* st;
};

__device__ __forceinline__ XcdBarrier xcd_barrier_post(unsigned* bar, volatile LAS unsigned* st) {
    XcdBarrier b; b.bar = bar; b.x = xb_xcc_id(); b.st = st;
    if (threadIdx.x == 0) (void)xb_add(&bar[XB_XCNT(b.x)], 1u);
    return b;
}
__device__ __forceinline__ void xcd_barrier_complete(unsigned* bar, unsigned x, unsigned& nloc, unsigned& nx) {
    const unsigned G = gridDim.x * gridDim.y * gridDim.z;
    unsigned sum, cnt, mine, sp = 0u;
    for (;;) {
        sum = 0u; cnt = 0u; mine = 0u;
#pragma unroll
        for (unsigned j = 0; j < 16; ++j) { const unsigned c = xb_ld(&bar[XB_XCNT(j)]); sum += c; cnt += (c > 0u) ? 1u : 0u; mine = (j == x) ? c : mine; }
        if (sum == G) break;
        __builtin_amdgcn_s_sleep(1);
        if ((++sp & 255u) == 0u) { if (xb_ld(&bar[XB_TMO])) break; if (sp > XB_SPIN_CAP) { atomicAdd(&bar[XB_TMO], 1u); break; } }
    }
    nloc = mine > 0u ? mine : 1u; nx = cnt > 0u ? cnt : 1u;
}

__device__ __forceinline__ void xcd_barrier(const XcdBarrier& b) {
    asm volatile("s_waitcnt vmcnt(0)" ::: "memory");
    __syncthreads();
    if (threadIdx.x == 0) {
        unsigned* bar = b.bar;
        __builtin_amdgcn_s_waitcnt(0);
        unsigned nloc = b.st[0], nx = b.st[1];
        if (nloc == 0u) { xcd_barrier_complete(bar, b.x, nloc, nx); b.st[0] = nloc; b.st[1] = nx; }
        const unsigned old = xb_add(&bar[XB_XSUB(b.x)], 1u);
        const unsigned gen = old / nloc;
        if (old + 1u == (gen + 1u) * nloc) {
            __builtin_amdgcn_fence(__ATOMIC_RELEASE, "agent");
            asm volatile("s_waitcnt vmcnt(0)" ::: "memory");
            const unsigned og = xb_add(&bar[XB_TOP], 1u);
            const unsigned tg = og / nx;
            if (og + 1u == (tg + 1u) * nx) xb_add(&bar[XB_TOPGEN], 1u);
            else XB_SPIN(xb_ld(&bar[XB_TOPGEN]) == tg, bar);
            __builtin_amdgcn_fence(__ATOMIC_ACQUIRE, "agent");
            xb_add(&bar[XB_XGEN(b.x)], 1u);
            asm volatile("s_waitcnt vmcnt(0)" ::: "memory");
        } else {
            XB_SPIN(xb_ld(&bar[XB_XGEN(b.x)]) == gen, bar);
            __builtin_amdgcn_fence(__ATOMIC_ACQUIRE, "agent");
            asm volatile("s_waitcnt vmcnt(0)" ::: "memory");
        }
    }
    __syncthreads();
}

struct Frame {
    LAS unsigned char* lds;
    volatile LAS unsigned* MISC;
    gu32* ctl;
    int tid, lane, wave;
    int vcu, G;
    const float* in[25]; float* out; unsigned char* ws;
};
__device__ __forceinline__ float wave_sum(float v) {
#pragma unroll
    for (int o = 1; o < 64; o <<= 1) v += __shfl_xor(v, o);
    return v;
}
__device__ __forceinline__ float wave_max(float v) {
#pragma unroll
    for (int o = 1; o < 64; o <<= 1) v = fmaxf(v, __shfl_xor(v, o));
    return v;
}
__device__ __forceinline__ void p0_transpose_item(const float* W, int K, int N, bf16* WT, int k0, int n0, int dst0, LAS float* scr, int lane) {
#pragma unroll 8
    for (int i = 0; i < 32; ++i) { const int kk = 2 * i + (lane >> 5); scr[kk * 33 + (lane & 31)] = W[(size_t)(k0 + kk) * N + n0 + (lane & 31)]; }
    LDS_WAIT(); asm volatile("" ::: "memory");
    const int c = lane & 7;
#pragma unroll
    for (int j = 0; j < 4; ++j) { const int n = (lane >> 3) + 8 * j; const LAS float* s = scr + (8 * c) * 33 + n;
        v4u o; o.x = pk2(s[0 * 33], s[1 * 33]); o.y = pk2(s[2 * 33], s[3 * 33]); o.z = pk2(s[4 * 33], s[5 * 33]); o.w = pk2(s[6 * 33], s[7 * 33]);
        *(GAS v4u*)(WT + (size_t)(dst0 + n) * K + k0 + 8 * c) = o; }
    LDS_WAIT(); asm volatile("" ::: "memory");
}
__device__ __forceinline__ void rms_row_to_bf16(const float* xrow, const float* w, bf16* orow, int lane) {
    const GAS f32x4* xr = (const GAS f32x4*)xrow + lane; const GAS f32x4* wr_ = (const GAS f32x4*)w + lane;
    f32x4 v[4]; float s = 0.f;
#pragma unroll
    for (int j = 0; j < 4; ++j) { v[j] = xr[64 * j]; s += (v[j].x * v[j].x + v[j].y * v[j].y) + (v[j].z * v[j].z + v[j].w * v[j].w); }
    const float r = 1.0f / sqrtf(wave_sum(s) * (1.f / D) + EPS);
    GAS unsigned long long* o8 = (GAS unsigned long long*)orow + lane;
#pragma unroll
    for (int j = 0; j < 4; ++j) { const f32x4 g = wr_[64 * j]; o8[64 * j] = (unsigned long long)pk2(v[j].x * r * g.x, v[j].y * r * g.y) | ((unsigned long long)pk2(v[j].z * r * g.z, v[j].w * r * g.w) << 32); }
}
__device__ __forceinline__ void p0_prologue(Frame& F) {
    LAS float* scr = (LAS float*)(F.lds + RING_OFF + F.wave * 16384);
    const int gw = F.vcu * NWAVES + F.wave, NGW = F.G * NWAVES, lane = F.lane;
    bf16* Win_t = (bf16*)(F.ws + WS_WIN); bf16* Wo_t = (bf16*)(F.ws + WS_WO); bf16* Wgu_t = (bf16*)(F.ws + WS_WGU); bf16* Wd_t = (bf16*)(F.ws + WS_WD);
    constexpr int I_IN = (D / 64) * (INC / 32), I_O = (D / 64) * (D / 32), I_G = (D / 64) * (FF / 32), I_D = (FF / 64) * (D / 32);
    constexpr int NITEMS = I_IN + I_O + 2 * I_G + I_D;
    for (int it = gw; it < NITEMS; it += NGW) {
        int r = it;
        if (r < I_IN) { const int nblk = INC / 32, kb = r / nblk, n0 = (r % nblk) * 32; int dst;
            if (n0 < 1536) dst = n0; else if (n0 < 2048) { const int c = n0 - 1536; dst = 1536 + 256 * (c >> 7) + (c & 127); } else { const int c = n0 - 2048; dst = 1536 + 256 * (c >> 7) + 128 + (c & 127); }
            p0_transpose_item(F.in[9], D, INC, Win_t, kb * 64, n0, dst, scr, lane); continue; } r -= I_IN;
        if (r < I_O) { const int nblk = D / 32, kb = r / nblk, n0 = (r % nblk) * 32; p0_transpose_item(F.in[19], D, D, Wo_t, kb * 64, n0, n0, scr, lane); continue; } r -= I_O;
        if (r < 2 * I_G) { const int up = r >= I_G; if (up) r -= I_G; const int nblk = FF / 32, kb = r / nblk, n0 = (r % nblk) * 32; const int dst = 256 * (n0 >> 7) + 128 * up + (n0 & 127);
            p0_transpose_item(up ? F.in[23] : F.in[22], D, FF, Wgu_t, kb * 64, n0, dst, scr, lane); continue; } r -= 2 * I_G;
        { const int nblk = D / 32, kb = r / nblk, n0 = (r % nblk) * 32; p0_transpose_item(F.in[24], FF, D, Wd_t, kb * 64, n0, n0, scr, lane); }
    }
    bf16* XN = (bf16*)(F.ws + WS_XN);
    for (int m = gw; m < M_PAD; m += NGW) {
        if (m < ROW_DEC + DB) { const float* src = m < M_REAL ? F.in[0] + (size_t)m * D : (m < ROW_DEC ? F.in[6] + (size_t)(m - ROW_META) * D : F.in[1] + (size_t)(m - ROW_DEC) * D);
            rms_row_to_bf16(src, F.in[7], XN + (size_t)m * D, lane); }
        else { GAS v4u* o = (GAS v4u*)(XN + (size_t)m * D) + lane; o[0] = (v4u){0u, 0u, 0u, 0u}; o[64] = (v4u){0u, 0u, 0u, 0u}; }
    }
    bf16* Kb = (bf16*)(F.ws + WS_K); bf16* Vb = (bf16*)(F.ws + WS_V); bf16* Ub = (bf16*)(F.ws + WS_U);
    constexpr int J_KV = NB * 48 * 2, J_U = NB * 30, J_SC = DB * 29;
    for (int j = gw; j < J_KV + J_U + J_SC; j += NGW) {
        int r = j;
        if (r < J_KV) { const int which = r & 1; r >>= 1; const int b = r / 48, row = 16 + r % 48; GAS v4u* o = (GAS v4u*)((which ? Vb : Kb) + ((size_t)b * KVROWS + row) * 512) + lane; o[0] = (v4u){0u, 0u, 0u, 0u}; continue; } r -= J_KV;
        if (r < J_U) { const int b = r / 30, row = r % 30; GAS v4u* o = (GAS v4u*)(Ub + ((size_t)b * UROWS + row) * 512) + lane; o[0] = (v4u){0u, 0u, 0u, 0u}; continue; } r -= J_U;
        { const int d = r / 29, row = r % 29; const GAS f32x4* s = (const GAS f32x4*)(F.in[4] + ((size_t)d * 30 + row + 1) * 512) + lane; GAS f32x4* o = (GAS f32x4*)(F.out + O_CS + ((size_t)d * 30 + row) * 512) + lane;
          o[0] = s[0]; o[64] = s[64]; }
    }
}


typedef float f32x16 __attribute__((ext_vector_type(16)));
typedef unsigned u32x2 __attribute__((ext_vector_type(2)));
__device__ __forceinline__ int crow(int r, int hi) { return (r & 3) + 8 * (r >> 2) + 4 * hi; }
__device__ __forceinline__ float bf2f(unsigned short u) { return __uint_as_float((unsigned)u << 16); }
__device__ __forceinline__ unsigned cvtpk(float lo, float hi) { unsigned r; asm volatile("v_cvt_pk_bf16_f32 %0, %1, %2" : "=v"(r) : "v"(lo), "v"(hi)); return r; }
__device__ __forceinline__ float ex2(float x) { return __builtin_amdgcn_exp2f(x); }
__device__ __forceinline__ float sigm(float x) { return __builtin_amdgcn_rcpf(1.0f + ex2(-LOG2E * x)); }
__device__ __forceinline__ float diff_lambda(const Frame& F) {
    const float a = wave_sum(F.in[10][F.lane] * F.in[11][F.lane]), b = wave_sum(F.in[12][F.lane] * F.in[13][F.lane]);
    return __expf(a) - __expf(b) + LAMBDA_INIT;
}

__device__ __forceinline__ void conv_tile(Frame& F, int b, int s0) {
    LAS unsigned char* tile = F.lds + RING_OFF;
    LAS float* red = (LAS float*)(F.lds + RING_OFF + 98304);
    LAS float* stat = red + 256;
    const unsigned char* src = (const unsigned char*)((const bf16*)(F.ws + WS_U) + ((size_t)b * UROWS + NMETA + s0) * 512);
    for (int c = F.tid; c < 94 * 64; c += NWAVES * 64) *(LAS v4u*)(tile + c * 16) = *(const GAS v4u*)(src + (size_t)c * 16);
    __syncthreads();
    const int ch = F.tid;
    float cw[CW];
#pragma unroll
    for (int w = 0; w < CW; ++w) cw[w] = F.in[15][w * 512 + ch];
    const float cb = F.in[16][ch], lw = F.in[17][ch], lb = F.in[18][ch];
    bf16* MIX = (bf16*)(F.ws + WS_MIX);
    for (int c0 = 0; c0 < 64; c0 += 16) {
        float win[46];
#pragma unroll
        for (int j = 0; j < 46; ++j) win[j] = bf2f(*(const LAS unsigned short*)(tile + ((c0 + j) * 512 + ch) * 2));
        float y[16];
#pragma unroll
        for (int i = 0; i < 16; ++i) { float a = cb;
#pragma unroll
            for (int w = 0; w < CW; ++w) a += win[i + w] * cw[w];
            y[i] = a; }
#pragma unroll
        for (int i = 0; i < 16; ++i) { const float s1 = wave_sum(y[i]), s2 = wave_sum(y[i] * y[i]); if (F.lane == 0) { red[(i * 8 + F.wave) * 2] = s1; red[(i * 8 + F.wave) * 2 + 1] = s2; } }
        __syncthreads();
        if (F.tid < 32) { const int i = F.tid >> 1, k = F.tid & 1; float s = 0.f;
#pragma unroll
            for (int w = 0; w < 8; ++w) s += red[(i * 8 + w) * 2 + k];
            stat[i * 2 + k] = s; }
        __syncthreads();
#pragma unroll
        for (int i = 0; i < 16; ++i) { const float mean = stat[2 * i] * (1.f / 512.f), var = stat[2 * i + 1] * (1.f / 512.f) - mean * mean;
            float v = (y[i] - mean) * (1.0f / sqrtf(var + EPS)) * lw + lb; v = v * sigm(v);
            MIX[(size_t)(b * SEQ + s0 + c0 + i) * D + 512 + ch] = (bf16)f2bf(v); }
    }
    __syncthreads();
}

__device__ __forceinline__ void attn_unit(Frame& F, int b, int h, int qblk, float lam) {
    const int lane = F.lane, r32 = lane & 31, hh = lane >> 5, wave = F.wave, mj = wave >> 2, rg = wave & 3;
    LAS unsigned char* Ks = F.lds + RING_OFF;
    LAS unsigned char* Vt = F.lds + RING_OFF + 18432;
    LAS float* X = (LAS float*)(F.lds + RING_OFF + 40960);
    const bf16* Qb = (const bf16*)(F.ws + WS_Q); const bf16* Kb = (const bf16*)(F.ws + WS_K); const bf16* Vb = (const bf16*)(F.ws + WS_V);
    const int qrow = b * SEQ + qblk * 128 + rg * 32 + r32;
    bf16x8 qr[4];
#pragma unroll
    for (int ds = 0; ds < 4; ++ds) qr[ds] = *(const GAS bf16x8*)(Qb + (size_t)qrow * 512 + (2 * h + mj) * 64 + 16 * ds + 8 * hh);
    const float slope2 = exp2f(-2.0f * (float)(h + 1)) * LOG2E;
    const int qpos = NMETA + qblk * 128 + rg * 32 + r32;
    float m = -INFINITY, l = 0.f; f32x16 o[4];
#pragma unroll
    for (int i = 0; i < 4; ++i)
#pragma unroll
        for (int r = 0; r < 16; ++r) o[i][r] = 0.f;
    const int NT = 1 + 2 * (qblk + 1);
    for (int t = 0; t < NT; ++t) {
        __syncthreads();
        {   const bf16* kbase = Kb + ((size_t)b * KVROWS + 64 * t + lane) * 512 + (2 * h) * 64;
            const bf16* vbase = Vb + ((size_t)b * KVROWS + 64 * t + lane) * 512 + h * 128;
#pragma unroll
            for (int i = 0; i < 2; ++i) { const int c = wave + 8 * i;
                const v4u dk = *(const GAS v4u*)(kbase + c * 8); *(LAS v4u*)(Ks + ((c >> 3) * 64 + lane) * 144 + (c & 7) * 16) = dk;
                const v4u dv = *(const GAS v4u*)(vbase + c * 8);
#pragma unroll
                for (int e = 0; e < 8; ++e) { const unsigned short x = (unsigned short)((dv[e >> 1] >> (16 * (e & 1))) & 0xffffu); *(LAS unsigned short*)(Vt + ((8 * c + e) * 72 + lane) * 2) = x; } }
        }
        __syncthreads();
        f32x16 p0, p1;
#pragma unroll
        for (int r = 0; r < 16; ++r) { p0[r] = 0.f; p1[r] = 0.f; }
        {   const LAS unsigned char* kp = Ks + (mj * 64 + r32) * 144 + hh * 16;
#pragma unroll
            for (int ds = 0; ds < 4; ++ds) { const bf16x8 a0 = *(const LAS bf16x8*)(kp + ds * 32), a1 = *(const LAS bf16x8*)(kp + 32 * 144 + ds * 32);
                p0 = __builtin_amdgcn_mfma_f32_32x32x16_bf16(a0, qr[ds], p0, 0, 0, 0); p1 = __builtin_amdgcn_mfma_f32_32x32x16_bf16(a1, qr[ds], p1, 0, 0, 0); } }
        const int kb_pos = (t == 0) ? 0 : NMETA + 64 * (t - 1);
        float mx = -INFINITY;
#pragma unroll
        for (int r = 0; r < 16; ++r) { const int kv0 = crow(r, hh), kp0 = kb_pos + kv0, kp1 = kp0 + 32;
            const bool ok0 = (t == 0) ? (kv0 < NMETA) : (kp0 <= qpos), ok1 = (t == 0) ? false : (kp1 <= qpos);
            p0[r] = ok0 ? p0[r] + slope2 * (float)(kp0 - qpos) : -INFINITY; p1[r] = ok1 ? p1[r] + slope2 * (float)(kp1 - qpos) : -INFINITY;
            mx = fmaxf(mx, fmaxf(p0[r], p1[r])); }
        mx = fmaxf(mx, __shfl_xor(mx, 32));
        const float mn = fmaxf(m, mx), alpha = ex2(m - mn); m = mn;
        float rs = 0.f;
#pragma unroll
        for (int r = 0; r < 16; ++r) { p0[r] = ex2(p0[r] - mn); p1[r] = ex2(p1[r] - mn); rs += p0[r] + p1[r]; }
        l = l * alpha + rs;
#pragma unroll
        for (int i = 0; i < 4; ++i)
#pragma unroll
            for (int r = 0; r < 16; ++r) o[i][r] *= alpha;
        bf16x8 pf[4];
        { v4u w; w.x = cvtpk(p0[0], p0[1]); w.y = cvtpk(p0[2], p0[3]); w.z = cvtpk(p0[4], p0[5]); w.w = cvtpk(p0[6], p0[7]); pf[0] = __builtin_bit_cast(bf16x8, w);
          w.x = cvtpk(p0[8], p0[9]); w.y = cvtpk(p0[10], p0[11]); w.z = cvtpk(p0[12], p0[13]); w.w = cvtpk(p0[14], p0[15]); pf[1] = __builtin_bit_cast(bf16x8, w);
          w.x = cvtpk(p1[0], p1[1]); w.y = cvtpk(p1[2], p1[3]); w.z = cvtpk(p1[4], p1[5]); w.w = cvtpk(p1[6], p1[7]); pf[2] = __builtin_bit_cast(bf16x8, w);
          w.x = cvtpk(p1[8], p1[9]); w.y = cvtpk(p1[10], p1[11]); w.z = cvtpk(p1[12], p1[13]); w.w = cvtpk(p1[14], p1[15]); pf[3] = __builtin_bit_cast(bf16x8, w); }
#pragma unroll
        for (int db = 0; db < 4; ++db) { const LAS unsigned char* vp = Vt + ((32 * db + r32) * 72 + 4 * hh) * 2;
#pragma unroll
            for (int ks = 0; ks < 4; ++ks) { const u32x2 lo = *(const LAS u32x2*)(vp + 32 * ks), hi = *(const LAS u32x2*)(vp + 32 * ks + 16);
                const v4u a = (v4u){lo.x, lo.y, hi.x, hi.y};
                o[db] = __builtin_amdgcn_mfma_f32_32x32x16_bf16(__builtin_bit_cast(bf16x8, a), pf[ks], o[db], 0, 0, 0); } }
    }
    l += __shfl_xor(l, 32);
    const float inv = 1.0f / l;
    if (mj == 1) { const float sc = lam * inv;
#pragma unroll
        for (int db = 0; db < 4; ++db)
#pragma unroll
            for (int r = 0; r < 16; ++r) X[((rg * 64) + db * 16 + r) * 64 + lane] = o[db][r] * sc; }
    __syncthreads();
    if (mj == 0) { float ss = 0.f;
#pragma unroll
        for (int db = 0; db < 4; ++db)
#pragma unroll
            for (int r = 0; r < 16; ++r) { const float d = o[db][r] * inv - X[((rg * 64) + db * 16 + r) * 64 + lane]; o[db][r] = d; ss += d * d; }
        ss += __shfl_xor(ss, 32);
        const float rr = (1.0f / sqrtf(ss * (1.f / 128.f) + EPS)) * (1.0f - LAMBDA_INIT);
        bf16* MIX = (bf16*)(F.ws + WS_MIX) + (size_t)qrow * D + h * 128;
#pragma unroll
        for (int db = 0; db < 4; ++db)
#pragma unroll
            for (int g = 0; g < 4; ++g) { const int dv0 = 32 * db + 8 * g + 4 * hh; const f32x4 sw = *(const GAS f32x4*)(F.in[14] + dv0);
                u32x2 w; w.x = cvtpk(o[db][4 * g] * rr * sw.x, o[db][4 * g + 1] * rr * sw.y); w.y = cvtpk(o[db][4 * g + 2] * rr * sw.z, o[db][4 * g + 3] * rr * sw.w);
                *(GAS u32x2*)(MIX + dv0) = w; } }
    __syncthreads();
}

__device__ __forceinline__ void dec_attn_unit(Frame& F, int d, int sp) {
    const int lane = F.lane, wave = F.wave;
    const float* dcs = (const float*)(F.ws + WS_DEC);
    const GAS f32x4* qp = (const GAS f32x4*)(dcs + DC_Q + (size_t)d * 512 + 8 * lane);
    const f32x4 q0 = qp[0], q1 = qp[1];
    const int h = lane >> 4; const bool odd = (lane >> 3) & 1;
    const float slope2 = exp2f(-2.0f * (float)(h + 1)) * LOG2E;
    const int pidx = sp * 8 + wave; const int page = ((const int*)F.in[5])[d * NPAGES + pidx];
    const float* kp = F.in[2] + (size_t)page * (PAGE * 512) + 8 * lane; const float* vp = F.in[3] + (size_t)page * (PAGE * 512) + 8 * lane;
    float m = -INFINITY, l = 0.f, a0[8], a1[8];
#pragma unroll
    for (int e = 0; e < 8; ++e) { a0[e] = 0.f; a1[e] = 0.f; }
    for (int t0 = 0; t0 < PAGE; t0 += 4) {
        f32x4 k[4][2], v[4][2];
#pragma unroll
        for (int i = 0; i < 4; ++i) { const GAS f32x4* kr = (const GAS f32x4*)(kp + (size_t)(t0 + i) * 512); k[i][0] = kr[0]; k[i][1] = kr[1];
            const GAS f32x4* vr = (const GAS f32x4*)(vp + (size_t)(t0 + i) * 512); v[i][0] = vr[0]; v[i][1] = vr[1]; }
        float s[4]; float mb = -INFINITY;
#pragma unroll
        for (int i = 0; i < 4; ++i) { float pt = (k[i][0].x * q0.x + k[i][0].y * q0.y) + (k[i][0].z * q0.z + k[i][0].w * q0.w) + (k[i][1].x * q1.x + k[i][1].y * q1.y) + (k[i][1].z * q1.z + k[i][1].w * q1.w);
            pt += __shfl_xor(pt, 1); pt += __shfl_xor(pt, 2); pt += __shfl_xor(pt, 4);
            s[i] = pt - slope2 * (float)(PAST - (pidx * PAGE + t0 + i)); mb = fmaxf(mb, s[i]); }
        const float mn = fmaxf(m, mb), alpha = ex2(m - mn); m = mn;
        float p[4], rs = 0.f;
#pragma unroll
        for (int i = 0; i < 4; ++i) { p[i] = ex2(s[i] - mn); rs += p[i]; }
        l = l * alpha + rs;
        const float alpha_o = __shfl_xor(alpha, 8);
        const float al0 = odd ? alpha_o : alpha, al1 = odd ? alpha : alpha_o;
#pragma unroll
        for (int e = 0; e < 8; ++e) { a0[e] *= al0; a1[e] *= al1; }
#pragma unroll
        for (int i = 0; i < 4; ++i) { const float po = __shfl_xor(p[i], 8); const float pj0 = odd ? po : p[i], pj1 = odd ? p[i] : po;
            a0[0] += pj0 * v[i][0].x; a0[1] += pj0 * v[i][0].y; a0[2] += pj0 * v[i][0].z; a0[3] += pj0 * v[i][0].w; a0[4] += pj0 * v[i][1].x; a0[5] += pj0 * v[i][1].y; a0[6] += pj0 * v[i][1].z; a0[7] += pj0 * v[i][1].w;
            a1[0] += pj1 * v[i][0].x; a1[1] += pj1 * v[i][0].y; a1[2] += pj1 * v[i][0].z; a1[3] += pj1 * v[i][0].w; a1[4] += pj1 * v[i][1].x; a1[5] += pj1 * v[i][1].y; a1[6] += pj1 * v[i][1].z; a1[7] += pj1 * v[i][1].w; }
    }
    LAS float* Rml = (LAS float*)(F.lds + RING_OFF);
    LAS float* Racc = Rml + 128;
    if ((lane & 7) == 0) { Rml[wave * 16 + (lane >> 3)] = m; Rml[wave * 16 + 8 + (lane >> 3)] = l; }
#pragma unroll
    for (int e = 0; e < 8; ++e) { Racc[(wave * 16 + e) * 64 + lane] = a0[e]; Racc[(wave * 16 + 8 + e) * 64 + lane] = a1[e]; }
    __syncthreads();
    if (wave == 0) {
        float* part = (float*)(F.ws + WS_DEC) + DC_PART + ((size_t)(d * NSPLIT + sp) * 8) * 132;
#pragma unroll
        for (int j = 0; j < 2; ++j) { const int hj = 2 * h + j; float M = -INFINITY;
#pragma unroll
            for (int w = 0; w < 8; ++w) M = fmaxf(M, Rml[w * 16 + hj]);
            float L = 0.f, acc[8];
#pragma unroll
            for (int e = 0; e < 8; ++e) acc[e] = 0.f;
#pragma unroll
            for (int w = 0; w < 8; ++w) { const float f = ex2(Rml[w * 16 + hj] - M); L += Rml[w * 16 + 8 + hj] * f;
#pragma unroll
                for (int e = 0; e < 8; ++e) acc[e] += Racc[(w * 16 + 8 * j + e) * 64 + lane] * f; }
            float* o = part + (size_t)hj * 132 + 8 * (lane & 15);
            *(f32x4*)o = (f32x4){acc[0], acc[1], acc[2], acc[3]}; *(f32x4*)(o + 4) = (f32x4){acc[4], acc[5], acc[6], acc[7]};
            if ((lane & 15) == 0) { part[(size_t)hj * 132 + 128] = M; part[(size_t)hj * 132 + 129] = L; } }
    }
    __syncthreads();
}

__device__ __forceinline__ void dec_combine(Frame& F, int d, float lam) {
    const int lane = F.lane, wave = F.wave;
    float* dcs = (float*)(F.ws + WS_DEC);
    LAS float* ybuf = (LAS float*)(F.lds + RING_OFF);
    if (wave < 4) {
        const int h = wave; float od[2][2];
#pragma unroll
        for (int j = 0; j < 2; ++j) { const int hj = 2 * h + j;
            const float sn = wave_sum(dcs[DC_Q + (size_t)d * 512 + hj * 64 + lane] * F.out[O_KS + (size_t)d * 512 + hj * 64 + lane]);
            const float* part = dcs + DC_PART + ((size_t)d * NSPLIT * 8 + hj) * 132;
            float M = sn;
#pragma unroll
            for (int s = 0; s < NSPLIT; ++s) M = fmaxf(M, part[(size_t)s * 8 * 132 + 128]);
            const float fn = ex2(sn - M); float L = fn;
            float a0 = fn * F.out[O_VS + (size_t)d * 512 + h * 128 + 2 * lane], a1 = fn * F.out[O_VS + (size_t)d * 512 + h * 128 + 2 * lane + 1];
#pragma unroll
            for (int s = 0; s < NSPLIT; ++s) { const float* ps = part + (size_t)s * 8 * 132; const float f = ex2(ps[128] - M); L += ps[129] * f; a0 += ps[2 * lane] * f; a1 += ps[2 * lane + 1] * f; }
            od[j][0] = a0 / L; od[j][1] = a1 / L; }
        const float d0 = od[0][0] - lam * od[1][0], d1 = od[0][1] - lam * od[1][1];
        const float ss = wave_sum(d0 * d0 + d1 * d1);
        const float rr = (1.0f / sqrtf(ss * (1.f / 128.f) + EPS)) * (1.0f - LAMBDA_INIT);
        dcs[DC_MIX + (size_t)d * D + h * 128 + 2 * lane] = d0 * rr * F.in[14][2 * lane]; dcs[DC_MIX + (size_t)d * D + h * 128 + 2 * lane + 1] = d1 * rr * F.in[14][2 * lane + 1];
    } else {
#pragma unroll
        for (int k = 0; k < 2; ++k) { const int ch = (wave - 4) * 128 + k * 64 + lane; float a = F.in[16][ch];
            for (int w = 0; w < CW - 1; ++w) a += F.in[4][((size_t)d * 30 + w) * 512 + ch] * F.in[15][w * 512 + ch];
            a += F.out[O_CS + ((size_t)d * 30 + 29) * 512 + ch] * F.in[15][(CW - 1) * 512 + ch];
            ybuf[ch] = a; }
    }
    __syncthreads();
    if (wave >= 4) { float s1 = 0.f, s2 = 0.f;
#pragma unroll
        for (int i = 0; i < 8; ++i) { const float y = ybuf[i * 64 + lane]; s1 += y; s2 += y * y; }
        s1 = wave_sum(s1); s2 = wave_sum(s2);
        const float mean = s1 * (1.f / 512.f), var = s2 * (1.f / 512.f) - mean * mean, rstd = 1.0f / sqrtf(var + EPS);
#pragma unroll
        for (int k = 0; k < 2; ++k) { const int ch = (wave - 4) * 128 + k * 64 + lane; float v = (ybuf[ch] - mean) * rstd * F.in[17][ch] + F.in[18][ch]; v = v * sigm(v); dcs[DC_MIX + (size_t)d * D + 512 + ch] = v; }
    }
    __syncthreads();
}

template <int NC> __device__ __forceinline__ void dec_dot(const float* A, int lda, int K, const bf16* const (&w)[NC], float (&res)[4][NC], int wave, int lane) {
    float acc[4][NC];
#pragma unroll
    for (int r = 0; r < 4; ++r)
#pragma unroll
        for (int n = 0; n < NC; ++n) acc[r][n] = 0.f;
    for (int c = lane; c < K / 8; c += 64) {
        f32x4 a[4][2];
#pragma unroll
        for (int r = 0; r < 4; ++r) { const GAS f32x4* ap = (const GAS f32x4*)(A + (size_t)(4 * wave + r) * lda + 8 * c); a[r][0] = ap[0]; a[r][1] = ap[1]; }
#pragma unroll
        for (int n = 0; n < NC; ++n) { const v4u wv = *(const GAS v4u*)(w[n] + 8 * c); float wf[8];
#pragma unroll
            for (int e = 0; e < 4; ++e) { wf[2 * e] = __uint_as_float(wv[e] << 16); wf[2 * e + 1] = __uint_as_float(wv[e] & 0xffff0000u); }
#pragma unroll
            for (int r = 0; r < 4; ++r) acc[r][n] += (a[r][0].x * wf[0] + a[r][0].y * wf[1]) + (a[r][0].z * wf[2] + a[r][0].w * wf[3]) + (a[r][1].x * wf[4] + a[r][1].y * wf[5]) + (a[r][1].z * wf[6] + a[r][1].w * wf[7]); }
    }
#pragma unroll
    for (int r = 0; r < 4; ++r)
#pragma unroll
        for (int n = 0; n < NC; ++n) res[r][n] = wave_sum(acc[r][n]);
}
__device__ __forceinline__ void dec_norm1_row(Frame& F, int d) {
    float* dcs = (float*)(F.ws + WS_DEC); const int lane = F.lane;
    f32x4 mo[4], x[4]; float s = 0.f;
#pragma unroll
    for (int j = 0; j < 4; ++j) { mo[j] = *(const GAS f32x4*)(dcs + DC_MIXOUT + (size_t)d * D + 4 * lane + 256 * j); s += (mo[j].x * mo[j].x + mo[j].y * mo[j].y) + (mo[j].z * mo[j].z + mo[j].w * mo[j].w); }
    const float r = 1.0f / sqrtf(wave_sum(s) * (1.f / D) + EPS); float s2 = 0.f;
#pragma unroll
    for (int j = 0; j < 4; ++j) { const f32x4 g = *(const GAS f32x4*)(F.in[8] + 4 * lane + 256 * j); x[j] = *(const GAS f32x4*)(F.in[1] + (size_t)d * D + 4 * lane + 256 * j) + mo[j] * r * g;
        s2 += (x[j].x * x[j].x + x[j].y * x[j].y) + (x[j].z * x[j].z + x[j].w * x[j].w); *(GAS f32x4*)(dcs + DC_X1 + (size_t)d * D + 4 * lane + 256 * j) = x[j]; }
    const float r2 = 1.0f / sqrtf(wave_sum(s2) * (1.f / D) + EPS);
#pragma unroll
    for (int j = 0; j < 4; ++j) { const f32x4 g = *(const GAS f32x4*)(F.in[20] + 4 * lane + 256 * j); *(GAS f32x4*)(dcs + DC_H + (size_t)d * D + 4 * lane + 256 * j) = x[j] * r2 * g; }
}
__device__ __forceinline__ void dec_norm2_row(Frame& F, int d) {
    float* dcs = (float*)(F.ws + WS_DEC); const int lane = F.lane;
    f32x4 f[4]; float s = 0.f;
#pragma unroll
    for (int j = 0; j < 4; ++j) { f[j] = *(const GAS f32x4*)(dcs + DC_F + (size_t)d * D + 4 * lane + 256 * j); s += (f[j].x * f[j].x + f[j].y * f[j].y) + (f[j].z * f[j].z + f[j].w * f[j].w); }
    const float r = 1.0f / sqrtf(wave_sum(s) * (1.f / D) + EPS);
#pragma unroll
    for (int j = 0; j < 4; ++j) { const f32x4 g = *(const GAS f32x4*)(F.in[21] + 4 * lane + 256 * j);
        *(GAS f32x4*)(F.out + O_YS + (size_t)d * D + 4 * lane + 256 * j) = *(const GAS f32x4*)(dcs + DC_X1 + (size_t)d * D + 4 * lane + 256 * j) + f[j] * r * g; }
}
__device__ __forceinline__ void norm1_row(Frame& F, int row) {
    const int lane = F.lane; const float* mo_ = (const float*)(F.ws + WS_MIXOUT) + (size_t)row * D; float* x1_ = (float*)(F.ws + WS_X1) + (size_t)row * D; bf16* hn = (bf16*)(F.ws + WS_HN) + (size_t)row * D;
    f32x4 mo[4], x[4]; float s = 0.f;
#pragma unroll
    for (int j = 0; j < 4; ++j) { mo[j] = *(const GAS f32x4*)(mo_ + 4 * lane + 256 * j); s += (mo[j].x * mo[j].x + mo[j].y * mo[j].y) + (mo[j].z * mo[j].z + mo[j].w * mo[j].w); }
    const float r = 1.0f / sqrtf(wave_sum(s) * (1.f / D) + EPS); float s2 = 0.f;
#pragma unroll
    for (int j = 0; j < 4; ++j) { const f32x4 g = *(const GAS f32x4*)(F.in[8] + 4 * lane + 256 * j); x[j] = *(const GAS f32x4*)(F.in[0] + (size_t)row * D + 4 * lane + 256 * j) + mo[j] * r * g;
        s2 += (x[j].x * x[j].x + x[j].y * x[j].y) + (x[j].z * x[j].z + x[j].w * x[j].w); *(GAS f32x4*)(x1_ + 4 * lane + 256 * j) = x[j]; }
    const float r2 = 1.0f / sqrtf(wave_sum(s2) * (1.f / D) + EPS);
#pragma unroll
    for (int j = 0; j < 4; ++j) { const f32x4 g = *(const GAS f32x4*)(F.in[20] + 4 * lane + 256 * j); const f32x4 hv = x[j] * r2 * g;
        *(GAS u32x2*)(hn + 4 * lane + 256 * j) = (u32x2){pk2(hv.x, hv.y), pk2(hv.z, hv.w)}; }
}
__device__ __forceinline__ void norm2_row(Frame& F, int row) {
    const int lane = F.lane; const float* f_ = (const float*)(F.ws + WS_MIXOUT) + (size_t)row * D; const float* x1_ = (const float*)(F.ws + WS_X1) + (size_t)row * D;
    f32x4 f[4]; float s = 0.f;
#pragma unroll
    for (int j = 0; j < 4; ++j) { f[j] = *(const GAS f32x4*)(f_ + 4 * lane + 256 * j); s += (f[j].x * f[j].x + f[j].y * f[j].y) + (f[j].z * f[j].z + f[j].w * f[j].w); }
    const float r = 1.0f / sqrtf(wave_sum(s) * (1.f / D) + EPS);
#pragma unroll
    for (int j = 0; j < 4; ++j) { const f32x4 g = *(const GAS f32x4*)(F.in[21] + 4 * lane + 256 * j);
        *(GAS f32x4*)(F.out + O_YP + (size_t)row * D + 4 * lane + 256 * j) = *(const GAS f32x4*)(x1_ + 4 * lane + 256 * j) + f[j] * r * g; }
}
constexpr int PER_PHASE = 9;
#ifndef MK_N_LAUNCHES
#define MK_N_LAUNCHES 1
#endif
constexpr int N_LAUNCHES = MK_N_LAUNCHES;
struct Args { const float* in[25]; float* out; unsigned char* ws; int ph_lo, ph_hi; };
__global__ void __launch_bounds__(NWAVES * 64, 2) hymba_fwd(Args args) {
    extern __shared__ __attribute__((aligned(16))) unsigned char lds[];
    Frame F;
    F.lds = (LAS unsigned char*)lds;
    F.MISC = (volatile LAS unsigned*)(F.lds + MISC_OFF);
    F.tid = threadIdx.x; F.lane = F.tid & 63; F.wave = __builtin_amdgcn_readfirstlane(F.tid >> 6);
    F.G = gridDim.x; { const int bx = blockIdx.x; F.vcu = (F.G % 8 == 0) ? (bx % 8) * (F.G / 8) + bx / 8 : bx; }
#pragma unroll
    for (int i = 0; i < 25; ++i) F.in[i] = args.in[i];
    F.out = args.out; F.ws = args.ws;
    F.ctl = (gu32*)(args.ws + WS_CTL);
    for (int u = F.tid; u < (LDS_BYTES - LDSCTL_OFF) / 4; u += NWAVES * 64) ((LAS unsigned*)(F.lds + LDSCTL_OFF))[u] = 0u;
    __syncthreads();
    XcdBarrier bar; bar.bar = (unsigned*)(F.ctl + CW_BAR); bar.x = 0; bar.st = nullptr;
    if (N_LAUNCHES == 1) bar = xcd_barrier_post((unsigned*)(F.ctl + CW_BAR), F.MISC + 8);
#define GRID_BAR() do { if (N_LAUNCHES == 1) xcd_barrier(bar); } while (0)
    const int lo = args.ph_lo, hi = args.ph_hi;
#define IN(k) (lo <= (k) && (k) < hi)
#define BOTH(k) (IN(k) && IN((k) + 1))
    float* dcs = (float*)(F.ws + WS_DEC);
    const int gw = F.vcu * NWAVES + F.wave, NGW = F.G * NWAVES;

    if (IN(0)) { p0_prologue(F); if (BOTH(0)) GRID_BAR(); }

    if (IN(1)) {
        pg8::Gemm g{(const bf16*)(F.ws + WS_XN), (const bf16*)(F.ws + WS_WIN), M_PAD, INC, D}; pg8::StaticOrder S; S.init(M_PAD, INC, F.G, (int)blockIdx.x);
        pg8::EpiIn E{(bf16*)(F.ws + WS_Q), (bf16*)(F.ws + WS_K), (bf16*)(F.ws + WS_V), (bf16*)(F.ws + WS_U), F.out, dcs + DC_Q};
        pg8::gemm_phase<pg8::EpiIn, pg8::StaticOrder, true, true>(F.lds + RING_OFF, g, S, E);
        if (BOTH(1)) GRID_BAR();
    }

    if (IN(2)) {
        const float lam = diff_lambda(F);
        for (int p = F.vcu; p < NB * NH * 8; p += F.G) {
            const int b = p >> 5, h = (p >> 3) & 3, a = p & 7;
            attn_unit(F, b, h, 15 - a, lam); attn_unit(F, b, h, a, lam);
        }
        for (int t = F.vcu; t < M_REAL / 64; t += F.G) conv_tile(F, t >> 5, (t & 31) * 64);
        for (int u = F.vcu; u < DB * NSPLIT; u += F.G) dec_attn_unit(F, u >> 3, u & 7);
        if (BOTH(2)) GRID_BAR();
    }

    if (IN(3)) {
        if (F.vcu < DB) { const float lam = diff_lambda(F); dec_combine(F, F.vcu, lam); }
        pg8::Gemm g{(const bf16*)(F.ws + WS_MIX), (const bf16*)(F.ws + WS_WO), M_REAL, D, D}; pg8::StaticOrder S; S.init(M_REAL, D, F.G, (int)blockIdx.x);
        pg8::EpiF32 E{(float*)(F.ws + WS_MIXOUT), D};
        pg8::gemm_phase<pg8::EpiF32, pg8::StaticOrder, true, true>(F.lds + RING_OFF, g, S, E);
        if (BOTH(3)) GRID_BAR();
    }

    if (IN(4)) {
        for (int c0 = 4 * F.vcu; c0 < D; c0 += 4 * F.G) {
            const bf16* Wo_t = (const bf16*)(F.ws + WS_WO); const bf16* const w[4] = {Wo_t + (size_t)c0 * D, Wo_t + (size_t)(c0 + 1) * D, Wo_t + (size_t)(c0 + 2) * D, Wo_t + (size_t)(c0 + 3) * D};
            float res[4][4]; dec_dot<4>(dcs + DC_MIX, D, D, w, res, F.wave, F.lane);
            if (F.lane == 0) {
#pragma unroll
                for (int r = 0; r < 4; ++r)
#pragma unroll
                    for (int n = 0; n < 4; ++n) dcs[DC_MIXOUT + (size_t)(4 * F.wave + r) * D + c0 + n] = res[r][n]; }
        }
        for (int m = gw; m < M_REAL; m += NGW) norm1_row(F, m);
        if (BOTH(4)) GRID_BAR();
    }

    if (IN(5)) {
        if (F.vcu < DB && F.wave == 0) dec_norm1_row(F, F.vcu);
        pg8::Gemm g{(const bf16*)(F.ws + WS_HN), (const bf16*)(F.ws + WS_WGU), M_REAL, 2 * FF, D}; pg8::StaticOrder S; S.init(M_REAL, 2 * FF, F.G, (int)blockIdx.x);
        pg8::EpiSwiGLU E{(bf16*)(F.ws + WS_ACT)};
        pg8::gemm_phase<pg8::EpiSwiGLU, pg8::StaticOrder, true, true>(F.lds + RING_OFF, g, S, E);
        if (BOTH(5)) GRID_BAR();
    }

    if (IN(6)) {
        for (int ch0 = 11 * F.vcu; ch0 < FF; ch0 += 11 * F.G) {
            for (int i = 0; i < 11; ++i) { const int ch = ch0 + i; const bf16* wg = (const bf16*)(F.ws + WS_WGU) + (size_t)(256 * (ch >> 7) + (ch & 127)) * D; const bf16* const w[2] = {wg, wg + (size_t)128 * D};
                float res[4][2]; dec_dot<2>(dcs + DC_H, D, D, w, res, F.wave, F.lane);
                if (F.lane == 0) {
#pragma unroll
                    for (int r = 0; r < 4; ++r) dcs[DC_ACT + (size_t)(4 * F.wave + r) * FF + ch] = res[r][0] * sigm(res[r][0]) * res[r][1]; } }
        }
        pg8::Gemm g{(const bf16*)(F.ws + WS_ACT), (const bf16*)(F.ws + WS_WD), M_REAL, D, FF}; pg8::StaticOrder S; S.init(M_REAL, D, F.G, (int)blockIdx.x);
        pg8::EpiF32 E{(float*)(F.ws + WS_MIXOUT), D};
        pg8::gemm_phase<pg8::EpiF32, pg8::StaticOrder, true, true>(F.lds + RING_OFF, g, S, E);
        if (BOTH(6)) GRID_BAR();
    }

    if (IN(7)) {
        for (int c0 = 4 * F.vcu; c0 < D; c0 += 4 * F.G) {
            const bf16* Wd_t = (const bf16*)(F.ws + WS_WD); const bf16* const w[4] = {Wd_t + (size_t)c0 * FF, Wd_t + (size_t)(c0 + 1) * FF, Wd_t + (size_t)(c0 + 2) * FF, Wd_t + (size_t)(c0 + 3) * FF};
            float res[4][4]; dec_dot<4>(dcs + DC_ACT, FF, FF, w, res, F.wave, F.lane);
            if (F.lane == 0) {
#pragma unroll
                for (int r = 0; r < 4; ++r)
#pragma unroll
                    for (int n = 0; n < 4; ++n) dcs[DC_F + (size_t)(4 * F.wave + r) * D + c0 + n] = res[r][n]; }
        }
        for (int m = gw; m < M_REAL; m += NGW) norm2_row(F, m);
        if (BOTH(7)) GRID_BAR();
    }

    if (IN(8)) { if (F.vcu < DB && F.wave == 0) dec_norm2_row(F, F.vcu); }
#undef IN
#undef BOTH
}

extern "C" void kernel_launch(void* const* d_in, const int* in_sizes, int n_in, void* d_out, int out_size, void* d_ws, size_t ws_size, hipStream_t stream) {
    static int grid = 0;
    if (grid == 0) {
        if (n_in != 25 || out_size != (int)O_END || ws_size < WS_END) { fprintf(stderr, "kernel_launch: unexpected shapes (n_in %d out %d ws %zu)\n", n_in, out_size, ws_size); grid = -1; return; }
        int dev = 0, cus = 0, per_cu = 0;
        if (hipGetDevice(&dev) != hipSuccess || hipDeviceGetAttribute(&cus, hipDeviceAttributeMultiprocessorCount, dev) != hipSuccess) { grid = -1; return; }
        if (hipFuncSetAttribute((const void*)hymba_fwd, hipFuncAttributeMaxDynamicSharedMemorySize, LDS_BYTES) != hipSuccess) { fprintf(stderr, "kernel_launch: hipFuncSetAttribute failed\n"); grid = -1; return; }
        if (hipOccupancyMaxActiveBlocksPerMultiprocessor(&per_cu, (const void*)hymba_fwd, NWAVES * 64, LDS_BYTES) != hipSuccess || per_cu < 1)
            fprintf(stderr, "kernel_launch: note: occupancy query reports %d workgroups per CU\n", per_cu);
        (void)hipGetLastError();
        grid = cus;
    }
    if (grid < 0) return;
    if (hipMemsetAsync((char*)d_ws + WS_CTL, 0, CTL_ZERO_BYTES, stream) != hipSuccess) return;
    Args a{};
    for (int i = 0; i < 25; ++i) a.in[i] = (const float*)d_in[i];
    a.out = (float*)d_out; a.ws = (unsigned char*)d_ws;
    if (N_LAUNCHES == 1) { a.ph_lo = 0; a.ph_hi = PER_PHASE; hipLaunchKernelGGL(hymba_fwd, dim3(grid), dim3(NWAVES * 64), LDS_BYTES, stream, a); }
    else for (int li = 0; li < PER_PHASE; ++li) { a.ph_lo = li; a.ph_hi = li + 1; hipLaunchKernelGGL(hymba_fwd, dim3(grid), dim3(NWAVES * 64), LDS_BYTES, stream, a); }
}
```

```cpp
#include <hip/hip_runtime.h>
#include <cstdio>
#include <cstdint>

constexpr int D = 1024, NB = 8, SEQ = 2048, NMETA = 16, TT = NMETA + SEQ  , DB = 32, PAST = 8192, PAGE = 128, NPAGES = PAST / PAGE;
constexpr int NH = 4, HD = 64, DV = 128, AW = 512, CD = 512, CW = 31, FF = 2816, INC = 2560;
constexpr int M_REAL = NB * SEQ;
constexpr int ROW_META = M_REAL;
constexpr int ROW_DEC = M_REAL + NMETA;
constexpr int M_PAD = M_REAL + 256;
constexpr int KVROWS = 64 + SEQ;
constexpr int UROWS = 30 + TT;
constexpr float EPS = 1e-6f;
constexpr float LOG2E = 1.4426950408889634f;
constexpr float QSCALE = 0.125f * LOG2E;
constexpr float LAMBDA_INIT = 0.2f;

constexpr size_t O_YP = 0, O_YS = O_YP + (size_t)M_REAL * D, O_KP = O_YS + (size_t)DB * D, O_VP = O_KP + (size_t)NB * TT * 512,
                 O_CP = O_VP + (size_t)NB * TT * 512, O_KS = O_CP + (size_t)NB * 30 * 512, O_VS = O_KS + (size_t)DB * 512, O_CS = O_VS + (size_t)DB * 512,
                 O_END = O_CS + (size_t)DB * 30 * 512;
static_assert(O_END == 34365440, "d_out size");

namespace pg8 {
#define PG8_LAS __attribute__((address_space(3)))
typedef unsigned short bf16_t;
typedef short bf16x8 __attribute__((ext_vector_type(8)));
typedef float f32x4 __attribute__((ext_vector_type(4)));
typedef unsigned u32x4 __attribute__((ext_vector_type(4)));
constexpr int BM = 256, BK = 64, HALF = 128, HTB = HALF * BK * 2  , STAGE_BYTES = 8 * HTB, NXCD = 8, WGM = 8;

__host__ __device__ __forceinline__ int lds_byte(int r, int c) { const int st = (r >> 4) * 2 + (c >> 5), rr = r & 15, cc = c & 31, ob = rr * 64 + cc * 2; return st * 1024 + (ob ^ (((ob >> 9) & 1) << 5)); }
__host__ __device__ __forceinline__ void stage_rc(int b, int& R, int& C) { const int st = b / 1024, sb = b % 1024, swz = sb ^ (((sb >> 9) & 1) << 5); R = (st >> 1) * 16 + swz / 64; C = (st & 1) * 32 + (swz % 64) / 2; }
__host__ __device__ __forceinline__ int perm32(int rho) { const int n = rho >> 4, i = rho & 15; return 8 * (i >> 2) + 4 * n + (i & 3); }

struct Unit { int pm, pn; };
struct Gemm { const bf16_t* A; const bf16_t* Bt; int M, N, K; };

struct StaticOrder {
    int nM, nN, nwg, G, c;
    __host__ __device__ void init(int M, int N, int G_, int c_) { nM = M / BM; nN = N / BM; nwg = nM * nN; G = G_; c = c_; }
    __host__ __device__ bool next(int i, Unit& u) const {
        const long L = (long)i * G + c; if (L >= nwg) return false;
        int wgid = (int)L; { const int q = nwg / NXCD, r = nwg % NXCD, xcd = wgid % NXCD, off = wgid / NXCD; wgid = (xcd < r ? xcd * (q + 1) : r * (q + 1) + (xcd - r) * q) + off; }
        const int nig = WGM * nN, gid = wgid / nig, fm = gid * WGM, gsz = (nM - fm) < WGM ? (nM - fm) : WGM;
        u.pm = fm + ((wgid % nig) % gsz); u.pn = (wgid % nig) / gsz; return true;
    }
    __device__ __forceinline__ void a_ready(const Unit&) const {}
    __device__ __forceinline__ void done(const Unit&) const {}
};

__device__ __forceinline__ unsigned cvt_pk_bf16(float lo, float hi) { unsigned r; asm volatile("v_cvt_pk_bf16_f32 %0, %1, %2" : "=v"(r) : "v"(lo), "v"(hi)); return r; }
typedef float f32x2 __attribute__((ext_vector_type(2)));
__device__ __forceinline__ u32x4 pack8(const f32x4& v0, const f32x4& v1) { u32x4 w; w.x = cvt_pk_bf16(v0[0], v0[1]); w.y = cvt_pk_bf16(v0[2], v0[3]); w.z = cvt_pk_bf16(v1[0], v1[1]); w.w = cvt_pk_bf16(v1[2], v1[3]); return w; }
__device__ __forceinline__ float sigmoidf_(float x) { return __builtin_amdgcn_rcpf(1.0f + __builtin_amdgcn_exp2f(-LOG2E * x)); }

struct EpiIn {
    static constexpr bool PERM = true, AFTER_DRAIN = false;
    bf16_t *Qb, *Kb, *Vb, *Ub; float* out; float* dcq;
    __device__ __forceinline__ void operator()(const f32x4 (&acc)[2][2][4][2], const Unit& u, int wr, int wc, int fr, int fq) const {
        asm volatile("" : "+v"(fr), "+v"(fq));
        const int pn = u.pn, cin = wc * 32 + 8 * fq;
        if (pn < 6) {
            const int kind = pn >> 1;
#pragma unroll
            for (int ai = 0; ai < 2; ++ai)
#pragma unroll
                for (int m = 0; m < 4; ++m) {
                    const int lrb = ai * HALF + wr * 64 + m * 16;
                    const int row = u.pm * BM + lrb + fr;
#pragma unroll
                    for (int bj = 0; bj < 2; ++bj) {
                        const int cc = (pn & 1) * 256 + bj * HALF + cin;
                        f32x4 v0 = acc[ai][bj][m][0], v1 = acc[ai][bj][m][1];
                        if (kind == 0) { v0 = v0 * QSCALE; v1 = v1 * QSCALE; *(u32x4*)(Qb + (size_t)row * 512 + cc) = pack8(v0, v1);
                            if (u.pm == M_REAL / BM && lrb >= 16 && lrb < 48) { float* o = dcq + (size_t)(lrb - 16 + fr) * 512 + cc; *(f32x4*)o = v0; *(f32x4*)(o + 4) = v1; } }
                        else {
                            bf16_t* bb = kind == 1 ? Kb : Vb; float* ob = out + (kind == 1 ? O_KP : O_VP); float* os = out + (kind == 1 ? O_KS : O_VS);
                            const u32x4 w = pack8(v0, v1);
                            if (u.pm < M_REAL / BM) { const int b = row >> 11, s = row & 2047;
                                float* o = ob + ((size_t)b * TT + NMETA + s) * 512 + cc; *(f32x4*)o = v0; *(f32x4*)(o + 4) = v1;
                                *(u32x4*)(bb + ((size_t)b * KVROWS + 64 + s) * 512 + cc) = w;
                            } else if (lrb == 0) {
                                for (int b = 0; b < NB; ++b) { float* o = ob + ((size_t)b * TT + fr) * 512 + cc; *(f32x4*)o = v0; *(f32x4*)(o + 4) = v1;
                                    *(u32x4*)(bb + ((size_t)b * KVROWS + fr) * 512 + cc) = w; }
                            } else if (lrb < 48) {
                                float* o = os + (size_t)(lrb - 16 + fr) * 512 + cc; *(f32x4*)o = v0; *(f32x4*)(o + 4) = v1;
                            }
                        }
                    }
                }
        } else {
            const int ch = (pn - 6) * HALF + cin;
#pragma unroll
            for (int ai = 0; ai < 2; ++ai)
#pragma unroll
                for (int m = 0; m < 4; ++m) {
                    const int lrb = ai * HALF + wr * 64 + m * 16; const int row = u.pm * BM + lrb + fr;
                    const f32x4 a0 = acc[ai][0][m][0], a1 = acc[ai][0][m][1], g0 = acc[ai][1][m][0], g1 = acc[ai][1][m][1];
                    f32x4 u0, u1;
#pragma unroll
                    for (int i = 0; i < 4; ++i) { u0[i] = a0[i] * sigmoidf_(g0[i]); u1[i] = a1[i] * sigmoidf_(g1[i]); }
                    const u32x4 w = pack8(u0, u1);
                    if (u.pm < M_REAL / BM) { const int b = row >> 11, s = row & 2047;
                        *(u32x4*)(Ub + ((size_t)b * UROWS + 30 + NMETA + s) * 512 + ch) = w;
                        if (s >= SEQ - 30) { float* o = out + O_CP + ((size_t)b * 30 + (s - (SEQ - 30))) * 512 + ch; *(f32x4*)o = u0; *(f32x4*)(o + 4) = u1; }
                    } else if (lrb == 0) {
                        for (int b = 0; b < NB; ++b) *(u32x4*)(Ub + ((size_t)b * UROWS + 30 + fr) * 512 + ch) = w;
                    } else if (lrb < 48) {
                        float* o = out + O_CS + ((size_t)(lrb - 16 + fr) * 30 + 29) * 512 + ch; *(f32x4*)o = u0; *(f32x4*)(o + 4) = u1;
                    }
                }
        }
    }
};
struct EpiF32 {
    static constexpr bool PERM = true, AFTER_DRAIN = false;
    float* O; int ldc;
    __device__ __forceinline__ void operator()(const f32x4 (&acc)[2][2][4][2], const Unit& u, int wr, int wc, int fr, int fq) const {
#pragma unroll
        for (int ai = 0; ai < 2; ++ai)
#pragma unroll
            for (int m = 0; m < 4; ++m) { float* rowp = O + (size_t)(u.pm * BM + ai * HALF + wr * 64 + m * 16 + fr) * ldc + u.pn * BM + wc * 32 + 8 * fq;
#pragma unroll
                for (int bj = 0; bj < 2; ++bj) { *(f32x4*)(rowp + bj * HALF) = acc[ai][bj][m][0]; *(f32x4*)(rowp + bj * HALF + 4) = acc[ai][bj][m][1]; } }
    }
};
struct EpiSwiGLU {
    static constexpr bool PERM = true, AFTER_DRAIN = false;
    bf16_t* O;
    __device__ __forceinline__ void operator()(const f32x4 (&acc)[2][2][4][2], const Unit& u, int wr, int wc, int fr, int fq) const {
#pragma unroll
        for (int ai = 0; ai < 2; ++ai)
#pragma unroll
            for (int m = 0; m < 4; ++m) { bf16_t* rowp = O + (size_t)(u.pm * BM + ai * HALF + wr * 64 + m * 16 + fr) * FF + u.pn * HALF + wc * 32 + 8 * fq;
                const f32x4 g0 = acc[ai][0][m][0], g1 = acc[ai][0][m][1], p0 = acc[ai][1][m][0], p1 = acc[ai][1][m][1]; f32x4 r0, r1;
#pragma unroll
                for (int i = 0; i < 4; ++i) { r0[i] = g0[i] * sigmoidf_(g0[i]) * p0[i]; r1[i] = g1[i] * sigmoidf_(g1[i]) * p1[i]; }
                *(u32x4*)rowp = pack8(r0, r1); }
    }
};

template <class Epi, class Sched, bool ALIGN_EPI = false, bool SP2 = false>
__device__ __forceinline__ void gemm_phase(PG8_LAS unsigned char* lds, const Gemm g, const Sched& S, const Epi& E) {
    const int tid = threadIdx.x, wid = __builtin_amdgcn_readfirstlane(tid >> 6), lane = tid & 63, wr = wid >> 2, wc = wid & 3, fr = lane & 15, fq = lane >> 4;
    const int K = g.K, nt = K / BK;
    unsigned voffA[2], voffB[2];
#pragma unroll
    for (int i = 0; i < 2; ++i) { int R, C; stage_rc(tid * 16 + i * 8192, R, C); const int Rb = Epi::PERM ? ((R & ~31) + perm32(R & 31)) : R;
        voffA[i] = (unsigned)(R * K + C) * 2u; voffB[i] = (unsigned)(Rb * K + C) * 2u; }
    const size_t kstep = (size_t)(BK * 2);
    const size_t hstep = (size_t)HALF * K * 2;
    const size_t tstep = 2 * hstep;
    const unsigned ldsw = (unsigned)wid * 1024u;
    const int aoff = lds_byte(wr * 64 + fr, fq * 8), boff = lds_byte(wc * 32 + fr, fq * 8);
#define PG8_SA(b, h) (((b) * 2 + (h)) * HTB)
#define PG8_SB(b, h) ((4 + (b) * 2 + (h)) * HTB)
#define PG8_STAGE(bufoff, gbase, voff) do { _Pragma("unroll") for (int _i = 0; _i < 2; ++_i) \
        __builtin_amdgcn_global_load_lds((const unsigned*)((const char*)(gbase) + (voff)[_i]), (PG8_LAS unsigned*)(lds + (bufoff) + ldsw + _i * 8192), 16, 0, 0); } while (0)
#define PG8_LDA(dst, b, h) do { _Pragma("unroll") for (int m = 0; m < 4; ++m) _Pragma("unroll") for (int k = 0; k < 2; ++k) dst[m][k] = *(const PG8_LAS bf16x8*)(lds + PG8_SA(b, h) + aoff + m * 2048 + k * 1024); } while (0)
#define PG8_LDB(dst, b, h) do { _Pragma("unroll") for (int n = 0; n < 2; ++n) _Pragma("unroll") for (int k = 0; k < 2; ++k) dst[n][k] = *(const PG8_LAS bf16x8*)(lds + PG8_SB(b, h) + boff + n * 2048 + k * 1024); } while (0)
#define PG8_MMA(ai, bj, At, Bt) do { __builtin_amdgcn_s_setprio(1); _Pragma("unroll") for (int m = 0; m < 4; ++m) _Pragma("unroll") for (int n = 0; n < 2; ++n) _Pragma("unroll") for (int k = 0; k < 2; ++k) \
        acc[ai][bj][m][n] = __builtin_amdgcn_mfma_f32_16x16x32_bf16(Bt[n][k], At[m][k], acc[ai][bj][m][n], 0, 0, 0); __builtin_amdgcn_s_setprio(0); } while (0)
#define PG8_WAIT_V(n) asm volatile("s_waitcnt vmcnt(" #n ")" ::: "memory")
#define PG8_WAIT_L(n) asm volatile("s_waitcnt lgkmcnt(" #n ")" ::: "memory")
#define PG8_BAR __builtin_amdgcn_s_barrier()
#define PG8_SCHED __builtin_amdgcn_sched_barrier(0)
    Unit cur, nxt; int ui = 0;
    if (!S.next(0, cur)) return;
    f32x4 acc[2][2][4][2];
#pragma unroll
    for (int a = 0; a < 2; ++a)
#pragma unroll
        for (int b = 0; b < 2; ++b)
#pragma unroll
            for (int m = 0; m < 4; ++m)
#pragma unroll
                for (int n = 0; n < 2; ++n) acc[a][b][m][n] = (f32x4){0.f, 0.f, 0.f, 0.f};
    bf16x8 At[4][2], B0[2][2], B1[2][2];
    const char* cA = (const char*)g.A + (size_t)cur.pm * tstep; const char* cB = (const char*)g.Bt + (size_t)cur.pn * tstep;
    S.a_ready(cur);
    if constexpr (SP2) {
        PG8_STAGE(PG8_SB(0, 0), cB, voffB); PG8_STAGE(PG8_SB(0, 1), cB + hstep, voffB); PG8_STAGE(PG8_SA(0, 0), cA, voffA); PG8_STAGE(PG8_SA(0, 1), cA + hstep, voffA);
        if (wr == 1) PG8_BAR;
        PG8_WAIT_V(2); PG8_BAR;
        PG8_STAGE(PG8_SB(1, 0), cB + kstep, voffB); PG8_STAGE(PG8_SA(1, 0), cA + kstep, voffA); PG8_STAGE(PG8_SB(1, 1), cB + hstep + kstep, voffB);
        PG8_WAIT_V(6); PG8_BAR;
    } else {
        PG8_STAGE(PG8_SB(0, 0), cB, voffB); PG8_STAGE(PG8_SA(0, 0), cA, voffA); PG8_STAGE(PG8_SB(0, 1), cB + hstep, voffB); PG8_STAGE(PG8_SA(0, 1), cA + hstep, voffA);
        if (wr == 1) PG8_BAR;
        PG8_WAIT_V(4); PG8_BAR;
        PG8_STAGE(PG8_SB(1, 0), cB + kstep, voffB); PG8_STAGE(PG8_SA(1, 0), cA + kstep, voffA); PG8_STAGE(PG8_SB(1, 1), cB + hstep + kstep, voffB);
        PG8_WAIT_V(6); PG8_BAR;
    }
    for (;;) {
        const bool has_next = S.next(ui + 1, nxt);
        const char* nA = has_next ? (const char*)g.A + (size_t)nxt.pm * tstep : cA; const char* nB = has_next ? (const char*)g.Bt + (size_t)nxt.pn * tstep : cB;
        for (int t = 0; t < nt; t += 2) {
            const bool last = (t == nt - 2);
            const char* a1 = cA + (size_t)(t + 1) * kstep;
            const char* a2 = last ? nA : cA + (size_t)(t + 2) * kstep; const char* b2 = last ? nB : cB + (size_t)(t + 2) * kstep;
            const char* a3 = a2 + kstep; const char* b3 = b2 + kstep;
            if (last && has_next) S.a_ready(nxt);
            if constexpr (SP2) {
            PG8_LDB(B0, 0, 0); PG8_LDB(B1, 0, 1); PG8_SCHED; PG8_LDA(At, 0, 0); PG8_STAGE(PG8_SA(1, 1), a1 + hstep, voffA);
            PG8_WAIT_V(8); PG8_WAIT_L(0); PG8_BAR; PG8_MMA(0, 0, At, B0); PG8_MMA(0, 1, At, B1); PG8_BAR; PG8_SCHED;
            PG8_LDA(At, 0, 1); PG8_STAGE(PG8_SB(0, 0), b2, voffB); PG8_STAGE(PG8_SB(0, 1), b2 + hstep, voffB); PG8_STAGE(PG8_SA(0, 0), a2, voffA);
            PG8_WAIT_V(8); PG8_WAIT_L(0); PG8_BAR; PG8_MMA(1, 0, At, B0); PG8_MMA(1, 1, At, B1); PG8_BAR; PG8_SCHED;
            PG8_LDB(B0, 1, 0); PG8_LDB(B1, 1, 1); PG8_SCHED; PG8_LDA(At, 1, 0); PG8_STAGE(PG8_SA(0, 1), a2 + hstep, voffA);
            PG8_WAIT_V(8); PG8_WAIT_L(0); PG8_BAR; PG8_MMA(0, 0, At, B0); PG8_MMA(0, 1, At, B1); PG8_BAR; PG8_SCHED;
            PG8_LDA(At, 1, 1); PG8_STAGE(PG8_SB(1, 0), b3, voffB); PG8_STAGE(PG8_SB(1, 1), b3 + hstep, voffB); PG8_STAGE(PG8_SA(1, 0), a3, voffA);
            PG8_WAIT_V(8); PG8_WAIT_L(0); PG8_BAR; PG8_MMA(1, 0, At, B0); PG8_MMA(1, 1, At, B1); PG8_BAR; PG8_SCHED;
            } else {
            PG8_LDB(B0, 0, 0); PG8_SCHED; PG8_LDA(At, 0, 0); PG8_STAGE(PG8_SA(1, 1), a1 + hstep, voffA);
            PG8_WAIT_L(8); PG8_BAR; PG8_WAIT_L(0); PG8_MMA(0, 0, At, B0); PG8_BAR; PG8_SCHED;
            PG8_LDB(B1, 0, 1); PG8_STAGE(PG8_SB(0, 0), b2, voffB);
            PG8_BAR; PG8_WAIT_L(0); PG8_MMA(0, 1, At, B1); PG8_BAR;
            PG8_LDA(At, 0, 1); PG8_STAGE(PG8_SA(0, 0), a2, voffA);
            PG8_BAR; PG8_WAIT_L(0); PG8_MMA(1, 0, At, B0); PG8_BAR; PG8_SCHED;
            PG8_STAGE(PG8_SB(0, 1), b2 + hstep, voffB);
            PG8_WAIT_V(6); PG8_BAR; PG8_MMA(1, 1, At, B1); PG8_BAR;
            PG8_LDB(B0, 1, 0); PG8_SCHED; PG8_LDA(At, 1, 0); PG8_STAGE(PG8_SA(0, 1), a2 + hstep, voffA);
            PG8_WAIT_L(8); PG8_BAR; PG8_WAIT_L(0); PG8_MMA(0, 0, At, B0); PG8_BAR; PG8_SCHED;
            PG8_LDB(B1, 1, 1); PG8_STAGE(PG8_SB(1, 0), b3, voffB);
            PG8_BAR; PG8_WAIT_L(0); PG8_MMA(0, 1, At, B1); PG8_BAR;
            PG8_LDA(At, 1, 1); PG8_STAGE(PG8_SA(1, 0), a3, voffA);
            PG8_BAR; PG8_WAIT_L(0); PG8_MMA(1, 0, At, B0); PG8_BAR; PG8_SCHED;
            PG8_STAGE(PG8_SB(1, 1), b3 + hstep, voffB);
            PG8_WAIT_V(6); PG8_BAR; PG8_MMA(1, 1, At, B1); PG8_BAR;
            }
        }
        if constexpr (ALIGN_EPI) { if (wr == 0) PG8_BAR; }
        if constexpr (!Epi::AFTER_DRAIN) { E(acc, cur, wr, wc, fr, fq); S.done(cur); }
        if (!has_next) break;
#pragma unroll
        for (int a = 0; a < 2; ++a)
#pragma unroll
            for (int b = 0; b < 2; ++b)
#pragma unroll
                for (int m = 0; m < 4; ++m)
#pragma unroll
                    for (int n = 0; n < 2; ++n) acc[a][b][m][n] = (f32x4){0.f, 0.f, 0.f, 0.f};
        cur = nxt; cA = nA; cB = nB; ++ui;
        if constexpr (ALIGN_EPI) { if (wr == 1) PG8_BAR; }
    }
    PG8_WAIT_V(0);
    if constexpr (!ALIGN_EPI) { if (wr == 0) PG8_BAR; }
    PG8_BAR;
    if constexpr (Epi::AFTER_DRAIN) { E.fused(acc, cur, wr, wc, fr, fq, lds, wid, lane); S.done(cur); }
#undef PG8_SA
#undef PG8_SB
#undef PG8_STAGE
#undef PG8_LDA
#undef PG8_LDB
#undef PG8_MMA
#undef PG8_WAIT_V
#undef PG8_WAIT_L
#undef PG8_BAR
#undef PG8_SCHED
}
}

constexpr size_t MiB = 1u << 20;
constexpr size_t WS_CTL = 0, CTL_ZERO_BYTES = 1 * MiB;
constexpr size_t WS_WIN = 2 * MiB;
constexpr size_t WS_WO = 8 * MiB;
constexpr size_t WS_WGU = 10 * MiB;
constexpr size_t WS_WD = 22 * MiB;
constexpr size_t WS_XN = 32 * MiB;
constexpr size_t WS_Q = 66 * MiB;
constexpr size_t WS_K = 84 * MiB;
constexpr size_t WS_V = 101 * MiB;
constexpr size_t WS_U = 118 * MiB;
constexpr size_t WS_MIX = 136 * MiB;
constexpr size_t WS_MIXOUT = 168 * MiB;
constexpr size_t WS_X1 = 232 * MiB;
constexpr size_t WS_HN = 296 * MiB;
constexpr size_t WS_ACT = 328 * MiB;
constexpr size_t WS_DEC = 416 * MiB;
constexpr size_t WS_END = 424 * MiB;
static_assert(WS_XN + (size_t)M_PAD * D * 2 <= WS_Q && WS_Q + (size_t)M_PAD * 512 * 2 <= WS_K && WS_K + (size_t)NB * KVROWS * 512 * 2 <= WS_V && WS_V + (size_t)NB * KVROWS * 512 * 2 <= WS_U &&
              WS_U + (size_t)NB * UROWS * 512 * 2 <= WS_MIX && WS_ACT + (size_t)M_REAL * FF * 2 <= WS_DEC, "d_ws map");
constexpr int NSPLIT = 8;
constexpr size_t DC_PART = 0;
constexpr size_t DC_MIX = DC_PART + (size_t)DB * NSPLIT * 8 * 132;
constexpr size_t DC_MIXOUT = DC_MIX + (size_t)DB * D;
constexpr size_t DC_X1 = DC_MIXOUT + (size_t)DB * D;
constexpr size_t DC_H = DC_X1 + (size_t)DB * D;
constexpr size_t DC_ACT = DC_H + (size_t)DB * D;
constexpr size_t DC_F = DC_ACT + (size_t)DB * FF;
constexpr size_t DC_Q = DC_F + (size_t)DB * D;
constexpr size_t DC_END = DC_Q + (size_t)DB * 512;
static_assert(DC_END * 4 <= 8 * MiB, "decode scratch");
constexpr int CW_TMO = 0, CW_CODE = 1;
constexpr int CW_BAR = 4096;

constexpr int NWAVES = 8;
constexpr int RING_OFF = 0, RING_BYTES = 131072;
constexpr int LDSCTL_OFF = RING_BYTES, MISC_OFF = LDSCTL_OFF + 320;
constexpr int LDS_BYTES = 147456;

#define GAS __attribute__((address_space(1)))
#define LAS __attribute__((address_space(3)))
typedef unsigned short bf16;
typedef unsigned v4u __attribute__((ext_vector_type(4)));
typedef float f32x4 __attribute__((ext_vector_type(4)));
typedef short bf16x8 __attribute__((ext_vector_type(8)));
typedef GAS unsigned gu32;
typedef GAS unsigned long long gu64;
#define RLX_AGENT __ATOMIC_RELAXED, __HIP_MEMORY_SCOPE_AGENT
#define LDS_WAIT() asm volatile("s_waitcnt lgkmcnt(0)" ::: "memory")
#define VM_WAIT() asm volatile("s_waitcnt vmcnt(0)" ::: "memory")
__device__ __forceinline__ unsigned long long rt() { return __builtin_amdgcn_s_memrealtime(); }
__device__ __forceinline__ unsigned f2bf(float f) { unsigned u = __builtin_bit_cast(unsigned, f); return (u + 0x7fffu + ((u >> 16) & 1u)) >> 16; }
__device__ __forceinline__ unsigned pk2(float lo, float hi) { return f2bf(lo) | (f2bf(hi) << 16); }

#define XB_TMO      128
#define XB_XCNT(j)  (256  + 64 * (j))
#define XB_XSUB(j)  (1280 + 64 * (j))
#define XB_XGEN(j)  (2304 + 64 * (j))
#define XB_TOP      3328
#define XB_TOPGEN   3392
#define XCD_BAR_WORDS 3456
#define XB_SPIN_CAP (1u << 18)

__device__ __forceinline__ unsigned xb_ld(unsigned* p)              { return __hip_atomic_load(p, __ATOMIC_RELAXED, __HIP_MEMORY_SCOPE_AGENT); }
__device__ __forceinline__ unsigned xb_add(unsigned* p, unsigned v) { return __hip_atomic_fetch_add(p, v, __ATOMIC_RELAXED, __HIP_MEMORY_SCOPE_AGENT); }
__device__ __forceinline__ unsigned xb_xcc_id() { return (unsigned)__builtin_amdgcn_s_getreg((3 << 11) | 20) & 0xFu; }
#define XB_SPIN(cond, bar) do { unsigned _sp = 0; while (cond) { __builtin_amdgcn_s_sleep(1); \
    if ((++_sp & 255u) == 0u) { if (xb_ld(&(bar)[XB_TMO])) break; if (_sp > XB_SPIN_CAP) { atomicAdd(&(bar)[XB_TMO], 1u); break; } } } } while (0)

struct XcdBarrier {
    unsigned* bar; unsigned x;
    volatile LAS unsigned* st;
};

__device__ __forceinline__ XcdBarrier xcd_barrier_post(unsigned* bar, volatile LAS unsigned* st) {
    XcdBarrier b; b.bar = bar; b.x = xb_xcc_id(); b.st = st;
    if (threadIdx.x == 0) (void)xb_add(&bar[XB_XCNT(b.x)], 1u);
    return b;
}
__device__ __forceinline__ void xcd_barrier_complete(unsigned* bar, unsigned x, unsigned& nloc, unsigned& nx) {
    const unsigned G = gridDim.x * gridDim.y * gridDim.z;
    unsigned sum, cnt, mine, sp = 0u;
    for (;;) {
        sum = 0u; cnt = 0u; mine = 0u;
#pragma unroll
        for (unsigned j = 0; j < 16; ++j) { const unsigned c = xb_ld(&bar[XB_XCNT(j)]); sum += c; cnt += (c > 0u) ? 1u : 0u; mine = (j == x) ? c : mine; }
        if (sum == G) break;
        __builtin_amdgcn_s_sleep(1);
        if ((++sp & 255u) == 0u) { if (xb_ld(&bar[XB_TMO])) break; if (sp > XB_SPIN_CAP) { atomicAdd(&bar[XB_TMO], 1u); break; } }
    }
    nloc = mine > 0u ? mine : 1u; nx = cnt > 0u ? cnt : 1u;
}

__device__ __forceinline__ void xcd_barrier(const XcdBarrier& b) {
    asm volatile("s_waitcnt vmcnt(0)" ::: "memory");
    __syncthreads();
    if (threadIdx.x == 0) {
        unsigned* bar = b.bar;
        __builtin_amdgcn_s_waitcnt(0);
        unsigned nloc = b.st[0], nx = b.st[1];
        if (nloc == 0u) { xcd_barrier_complete(bar, b.x, nloc, nx); b.st[0] = nloc; b.st[1] = nx; }
        const unsigned old = xb_add(&bar[XB_XSUB(b.x)], 1u);
        const unsigned gen = old / nloc;
        if (old + 1u == (gen + 1u) * nloc) {
            __builtin_amdgcn_fence(__ATOMIC_RELEASE, "agent");
            asm volatile("s_waitcnt vmcnt(0)" ::: "memory");
            const unsigned og = xb_add(&bar[XB_TOP], 1u);
            const unsigned tg = og / nx;
            if (og + 1u == (tg + 1u) * nx) xb_add(&bar[XB_TOPGEN], 1u);
            else XB_SPIN(xb_ld(&bar[XB_TOPGEN]) == tg, bar);
            __builtin_amdgcn_fence(__ATOMIC_ACQUIRE, "agent");
            xb_add(&bar[XB_XGEN(b.x)], 1u);
            asm volatile("s_waitcnt vmcnt(0)" ::: "memory");
        } else {
            XB_SPIN(xb_ld(&bar[XB_XGEN(b.x)]) == gen, bar);
            __builtin_amdgcn_fence(__ATOMIC_ACQUIRE, "agent");
            asm volatile("s_waitcnt vmcnt(0)" ::: "memory");
        }
    }
    __syncthreads();
}

struct Frame {
    LAS unsigned char* lds;
    volatile LAS unsigned* MISC;
    gu32* ctl;
    int tid, lane, wave;
    int vcu, G;
    const float* in[25]; float* out; unsigned char* ws;
};
__device__ __forceinline__ float wave_sum(float v) {
#pragma unroll
    for (int o = 1; o < 64; o <<= 1) v += __shfl_xor(v, o);
    return v;
}
__device__ __forceinline__ float wave_max(float v) {
#pragma unroll
    for (int o = 1; o < 64; o <<= 1) v = fmaxf(v, __shfl_xor(v, o));
    return v;
}
__device__ __forceinline__ void p0_transpose_item(const float* W, int K, int N, bf16* WT, int k0, int n0, int dst0, LAS float* scr, int lane) {
#pragma unroll 8
    for (int i = 0; i < 32; ++i) { const int kk = 2 * i + (lane >> 5); scr[kk * 33 + (lane & 31)] = W[(size_t)(k0 + kk) * N + n0 + (lane & 31)]; }
    LDS_WAIT(); asm volatile("" ::: "memory");
    const int c = lane & 7;
#pragma unroll
    for (int j = 0; j < 4; ++j) { const int n = (lane >> 3) + 8 * j; const LAS float* s = scr + (8 * c) * 33 + n;
        v4u o; o.x = pk2(s[0 * 33], s[1 * 33]); o.y = pk2(s[2 * 33], s[3 * 33]); o.z = pk2(s[4 * 33], s[5 * 33]); o.w = pk2(s[6 * 33], s[7 * 33]);
        *(GAS v4u*)(WT + (size_t)(dst0 + n) * K + k0 + 8 * c) = o; }
    LDS_WAIT(); asm volatile("" ::: "memory");
}
__device__ __forceinline__ void rms_row_to_bf16(const float* xrow, const float* w, bf16* orow, int lane) {
    const GAS f32x4* xr = (const GAS f32x4*)xrow + lane; const GAS f32x4* wr_ = (const GAS f32x4*)w + lane;
    f32x4 v[4]; float s = 0.f;
#pragma unroll
    for (int j = 0; j < 4; ++j) { v[j] = xr[64 * j]; s += (v[j].x * v[j].x + v[j].y * v[j].y) + (v[j].z * v[j].z + v[j].w * v[j].w); }
    const float r = 1.0f / sqrtf(wave_sum(s) * (1.f / D) + EPS);
    GAS unsigned long long* o8 = (GAS unsigned long long*)orow + lane;
#pragma unroll
    for (int j = 0; j < 4; ++j) { const f32x4 g = wr_[64 * j]; o8[64 * j] = (unsigned long long)pk2(v[j].x * r * g.x, v[j].y * r * g.y) | ((unsigned long long)pk2(v[j].z * r * g.z, v[j].w * r * g.w) << 32); }
}
__device__ __forceinline__ void p0_prologue(Frame& F) {
    LAS float* scr = (LAS float*)(F.lds + RING_OFF + F.wave * 16384);
    const int gw = F.vcu * NWAVES + F.wave, NGW = F.G * NWAVES, lane = F.lane;
    bf16* Win_t = (bf16*)(F.ws + WS_WIN); bf16* Wo_t = (bf16*)(F.ws + WS_WO); bf16* Wgu_t = (bf16*)(F.ws + WS_WGU); bf16* Wd_t = (bf16*)(F.ws + WS_WD);
    constexpr int I_IN = (D / 64) * (INC / 32), I_O = (D / 64) * (D / 32), I_G = (D / 64) * (FF / 32), I_D = (FF / 64) * (D / 32);
    constexpr int NITEMS = I_IN + I_O + 2 * I_G + I_D;
    for (int it = gw; it < NITEMS; it += NGW) {
        int r = it;
        if (r < I_IN) { const int nblk = INC / 32, kb = r / nblk, n0 = (r % nblk) * 32; int dst;
            if (n0 < 1536) dst = n0; else if (n0 < 2048) { const int c = n0 - 1536; dst = 1536 + 256 * (c >> 7) + (c & 127); } else { const int c = n0 - 2048; dst = 1536 + 256 * (c >> 7) + 128 + (c & 127); }
            p0_transpose_item(F.in[9], D, INC, Win_t, kb * 64, n0, dst, scr, lane); continue; } r -= I_IN;
        if (r < I_O) { const int nblk = D / 32, kb = r / nblk, n0 = (r % nblk) * 32; p0_transpose_item(F.in[19], D, D, Wo_t, kb * 64, n0, n0, scr, lane); continue; } r -= I_O;
        if (r < 2 * I_G) { const int up = r >= I_G; if (up) r -= I_G; const int nblk = FF / 32, kb = r / nblk, n0 = (r % nblk) * 32; const int dst = 256 * (n0 >> 7) + 128 * up + (n0 & 127);
            p0_transpose_item(up ? F.in[23] : F.in[22], D, FF, Wgu_t, kb * 64, n0, dst, scr, lane); continue; } r -= 2 * I_G;
        { const int nblk = D / 32, kb = r / nblk, n0 = (r % nblk) * 32; p0_transpose_item(F.in[24], FF, D, Wd_t, kb * 64, n0, n0, scr, lane); }
    }
    bf16* XN = (bf16*)(F.ws + WS_XN);
    for (int m = gw; m < M_PAD; m += NGW) {
        if (m < ROW_DEC + DB) { const float* src = m < M_REAL ? F.in[0] + (size_t)m * D : (m < ROW_DEC ? F.in[6] + (size_t)(m - ROW_META) * D : F.in[1] + (size_t)(m - ROW_DEC) * D);
            rms_row_to_bf16(src, F.in[7], XN + (size_t)m * D, lane); }
        else { GAS v4u* o = (GAS v4u*)(XN + (size_t)m * D) + lane; o[0] = (v4u){0u, 0u, 0u, 0u}; o[64] = (v4u){0u, 0u, 0u, 0u}; }
    }
    bf16* Kb = (bf16*)(F.ws + WS_K); bf16* Vb = (bf16*)(F.ws + WS_V); bf16* Ub = (bf16*)(F.ws + WS_U);
    constexpr int J_KV = NB * 48 * 2, J_U = NB * 30, J_SC = DB * 29;
    for (int j = gw; j < J_KV + J_U + J_SC; j += NGW) {
        int r = j;
        if (r < J_KV) { const int which = r & 1; r >>= 1; const int b = r / 48, row = 16 + r % 48; GAS v4u* o = (GAS v4u*)((which ? Vb : Kb) + ((size_t)b * KVROWS + row) * 512) + lane; o[0] = (v4u){0u, 0u, 0u, 0u}; continue; } r -= J_KV;
        if (r < J_U) { const int b = r / 30, row = r % 30; GAS v4u* o = (GAS v4u*)(Ub + ((size_t)b * UROWS + row) * 512) + lane; o[0] = (v4u){0u, 0u, 0u, 0u}; continue; } r -= J_U;
        { const int d = r / 29, row = r % 29; const GAS f32x4* s = (const GAS f32x4*)(F.in[4] + ((size_t)d * 30 + row + 1) * 512) + lane; GAS f32x4* o = (GAS f32x4*)(F.out + O_CS + ((size_t)d * 30 + row) * 512) + lane;
          o[0] = s[0]; o[64] = s[64]; }
    }
}


typedef float f32x16 __attribute__((ext_vector_type(16)));
typedef unsigned u32x2 __attribute__((ext_vector_type(2)));
__device__ __forceinline__ int crow(int r, int hi) { return (r & 3) + 8 * (r >> 2) + 4 * hi; }
__device__ __forceinline__ float bf2f(unsigned short u) { return __uint_as_float((unsigned)u << 16); }
__device__ __forceinline__ unsigned cvtpk(float lo, float hi) { unsigned r; asm volatile("v_cvt_pk_bf16_f32 %0, %1, %2" : "=v"(r) : "v"(lo), "v"(hi)); return r; }
__device__ __forceinline__ float ex2(float x) { return __builtin_amdgcn_exp2f(x); }
__device__ __forceinline__ float sigm(float x) { return __builtin_amdgcn_rcpf(1.0f + ex2(-LOG2E * x)); }
__device__ __forceinline__ float diff_lambda(const Frame& F) {
    const float a = wave_sum(F.in[10][F.lane] * F.in[11][F.lane]), b = wave_sum(F.in[12][F.lane] * F.in[13][F.lane]);
    return __expf(a) - __expf(b) + LAMBDA_INIT;
}

__device__ __forceinline__ void conv_tile(Frame& F, int b, int s0) {
    LAS unsigned char* tile = F.lds + RING_OFF;
    LAS float* red = (LAS float*)(F.lds + RING_OFF + 98304);
    LAS float* stat = red + 256;
    const unsigned char* src = (const unsigned char*)((const bf16*)(F.ws + WS_U) + ((size_t)b * UROWS + NMETA + s0) * 512);
    for (int c = F.tid; c < 94 * 64; c += NWAVES * 64) *(LAS v4u*)(tile + c * 16) = *(const GAS v4u*)(src + (size_t)c * 16);
    __syncthreads();
    const int ch = F.tid;
    float cw[CW];
#pragma unroll
    for (int w = 0; w < CW; ++w) cw[w] = F.in[15][w * 512 + ch];
    const float cb = F.in[16][ch], lw = F.in[17][ch], lb = F.in[18][ch];
    bf16* MIX = (bf16*)(F.ws + WS_MIX);
    for (int c0 = 0; c0 < 64; c0 += 16) {
        float win[46];
#pragma unroll
        for (int j = 0; j < 46; ++j) win[j] = bf2f(*(const LAS unsigned short*)(tile + ((c0 + j) * 512 + ch) * 2));
        float y[16];
#pragma unroll
        for (int i = 0; i < 16; ++i) { float a = cb;
#pragma unroll
            for (int w = 0; w < CW; ++w) a += win[i + w] * cw[w];
            y[i] = a; }
#pragma unroll
        for (int i = 0; i < 16; ++i) { const float s1 = wave_sum(y[i]), s2 = wave_sum(y[i] * y[i]); if (F.lane == 0) { red[(i * 8 + F.wave) * 2] = s1; red[(i * 8 + F.wave) * 2 + 1] = s2; } }
        __syncthreads();
        if (F.tid < 32) { const int i = F.tid >> 1, k = F.tid & 1; float s = 0.f;
#pragma unroll
            for (int w = 0; w < 8; ++w) s += red[(i * 8 + w) * 2 + k];
            stat[i * 2 + k] = s; }
        __syncthreads();
#pragma unroll
        for (int i = 0; i < 16; ++i) { const float mean = stat[2 * i] * (1.f / 512.f), var = stat[2 * i + 1] * (1.f / 512.f) - mean * mean;
            float v = (y[i] - mean) * (1.0f / sqrtf(var + EPS)) * lw + lb; v = v * sigm(v);
            MIX[(size_t)(b * SEQ + s0 + c0 + i) * D + 512 + ch] = (bf16)f2bf(v); }
    }
    __syncthreads();
}

__device__ __forceinline__ void attn_unit_slow(Frame& F, int b, int h, int qblk, float lam) {
    const int lane = F.lane, r32 = lane & 31, hh = lane >> 5, wave = F.wave, mj = wave >> 2, rg = wave & 3;
    LAS unsigned char* Ks = F.lds + RING_OFF;
    LAS unsigned char* Vt = F.lds + RING_OFF + 18432;
    LAS float* X = (LAS float*)(F.lds + RING_OFF + 40960);
    const bf16* Qb = (const bf16*)(F.ws + WS_Q); const bf16* Kb = (const bf16*)(F.ws + WS_K); const bf16* Vb = (const bf16*)(F.ws + WS_V);
    const int qrow = b * SEQ + qblk * 128 + rg * 32 + r32;
    bf16x8 qr[4];
#pragma unroll
    for (int ds = 0; ds < 4; ++ds) qr[ds] = *(const GAS bf16x8*)(Qb + (size_t)qrow * 512 + (2 * h + mj) * 64 + 16 * ds + 8 * hh);
    const float slope2 = exp2f(-2.0f * (float)(h + 1)) * LOG2E;
    const int qpos = NMETA + qblk * 128 + rg * 32 + r32;
    float m = -INFINITY, l = 0.f; f32x16 o[4];
#pragma unroll
    for (int i = 0; i < 4; ++i)
#pragma unroll
        for (int r = 0; r < 16; ++r) o[i][r] = 0.f;
    const int NT = 1 + 2 * (qblk + 1);
    for (int t = 0; t < NT; ++t) {
        __syncthreads();
        {   const bf16* kbase = Kb + ((size_t)b * KVROWS + 64 * t + lane) * 512 + (2 * h) * 64;
            const bf16* vbase = Vb + ((size_t)b * KVROWS + 64 * t + lane) * 512 + h * 128;
#pragma unroll
            for (int i = 0; i < 2; ++i) { const int c = wave + 8 * i;
                const v4u dk = *(const GAS v4u*)(kbase + c * 8); *(LAS v4u*)(Ks + ((c >> 3) * 64 + lane) * 144 + (c & 7) * 16) = dk;
                const v4u dv = *(const GAS v4u*)(vbase + c * 8);
#pragma unroll
                for (int e = 0; e < 8; ++e) { const unsigned short x = (unsigned short)((dv[e >> 1] >> (16 * (e & 1))) & 0xffffu); *(LAS unsigned short*)(Vt + ((8 * c + e) * 72 + lane) * 2) = x; } }
        }
        __syncthreads();
        f32x16 p0, p1;
#pragma unroll
        for (int r = 0; r < 16; ++r) { p0[r] = 0.f; p1[r] = 0.f; }
        {   const LAS unsigned char* kp = Ks + (mj * 64 + r32) * 144 + hh * 16;
#pragma unroll
            for (int ds = 0; ds < 4; ++ds) { const bf16x8 a0 = *(const LAS bf16x8*)(kp + ds * 32), a1 = *(const LAS bf16x8*)(kp + 32 * 144 + ds * 32);
                p0 = __builtin_amdgcn_mfma_f32_32x32x16_bf16(a0, qr[ds], p0, 0, 0, 0); p1 = __builtin_amdgcn_mfma_f32_32x32x16_bf16(a1, qr[ds], p1, 0, 0, 0); } }
        const int kb_pos = (t == 0) ? 0 : NMETA + 64 * (t - 1);
        float mx = -INFINITY;
#pragma unroll
        for (int r = 0; r < 16; ++r) { const int kv0 = crow(r, hh), kp0 = kb_pos + kv0, kp1 = kp0 + 32;
            const bool ok0 = (t == 0) ? (kv0 < NMETA) : (kp0 <= qpos), ok1 = (t == 0) ? false : (kp1 <= qpos);
            p0[r] = ok0 ? p0[r] + slope2 * (float)(kp0 - qpos) : -INFINITY; p1[r] = ok1 ? p1[r] + slope2 * (float)(kp1 - qpos) : -INFINITY;
            mx = fmaxf(mx, fmaxf(p0[r], p1[r])); }
        mx = fmaxf(mx, __shfl_xor(mx, 32));
        const float mn = fmaxf(m, mx), alpha = ex2(m - mn); m = mn;
        float rs = 0.f;
#pragma unroll
        for (int r = 0; r < 16; ++r) { p0[r] = ex2(p0[r] - mn); p1[r] = ex2(p1[r] - mn); rs += p0[r] + p1[r]; }
        l = l * alpha + rs;
#pragma unroll
        for (int i = 0; i < 4; ++i)
#pragma unroll
            for (int r = 0; r < 16; ++r) o[i][r] *= alpha;
        bf16x8 pf[4];
        { v4u w; w.x = cvtpk(p0[0], p0[1]); w.y = cvtpk(p0[2], p0[3]); w.z = cvtpk(p0[4], p0[5]); w.w = cvtpk(p0[6], p0[7]); pf[0] = __builtin_bit_cast(bf16x8, w);
          w.x = cvtpk(p0[8], p0[9]); w.y = cvtpk(p0[10], p0[11]); w.z = cvtpk(p0[12], p0[13]); w.w = cvtpk(p0[14], p0[15]); pf[1] = __builtin_bit_cast(bf16x8, w);
          w.x = cvtpk(p1[0], p1[1]); w.y = cvtpk(p1[2], p1[3]); w.z = cvtpk(p1[4], p1[5]); w.w = cvtpk(p1[6], p1[7]); pf[2] = __builtin_bit_cast(bf16x8, w);
          w.x = cvtpk(p1[8], p1[9]); w.y = cvtpk(p1[10], p1[11]); w.z = cvtpk(p1[12], p1[13]); w.w = cvtpk(p1[14], p1[15]); pf[3] = __builtin_bit_cast(bf16x8, w); }
#pragma unroll
        for (int db = 0; db < 4; ++db) { const LAS unsigned char* vp = Vt + ((32 * db + r32) * 72 + 4 * hh) * 2;
#pragma unroll
            for (int ks = 0; ks < 4; ++ks) { const u32x2 lo = *(const LAS u32x2*)(vp + 32 * ks), hi = *(const LAS u32x2*)(vp + 32 * ks + 16);
                const v4u a = (v4u){lo.x, lo.y, hi.x, hi.y};
                o[db] = __builtin_amdgcn_mfma_f32_32x32x16_bf16(__builtin_bit_cast(bf16x8, a), pf[ks], o[db], 0, 0, 0); } }
    }
    l += __shfl_xor(l, 32);
    const float inv = 1.0f / l;
    if (mj == 1) { const float sc = lam * inv;
#pragma unroll
        for (int db = 0; db < 4; ++db)
#pragma unroll
            for (int r = 0; r < 16; ++r) X[((rg * 64) + db * 16 + r) * 64 + lane] = o[db][r] * sc; }
    __syncthreads();
    if (mj == 0) { float ss = 0.f;
#pragma unroll
        for (int db = 0; db < 4; ++db)
#pragma unroll
            for (int r = 0; r < 16; ++r) { const float d = o[db][r] * inv - X[((rg * 64) + db * 16 + r) * 64 + lane]; o[db][r] = d; ss += d * d; }
        ss += __shfl_xor(ss, 32);
        const float rr = (1.0f / sqrtf(ss * (1.f / 128.f) + EPS)) * (1.0f - LAMBDA_INIT);
        bf16* MIX = (bf16*)(F.ws + WS_MIX) + (size_t)qrow * D + h * 128;
#pragma unroll
        for (int db = 0; db < 4; ++db)
#pragma unroll
            for (int g = 0; g < 4; ++g) { const int dv0 = 32 * db + 8 * g + 4 * hh; const f32x4 sw = *(const GAS f32x4*)(F.in[14] + dv0);
                u32x2 w; w.x = cvtpk(o[db][4 * g] * rr * sw.x, o[db][4 * g + 1] * rr * sw.y); w.y = cvtpk(o[db][4 * g + 2] * rr * sw.z, o[db][4 * g + 3] * rr * sw.w);
                *(GAS u32x2*)(MIX + dv0) = w; } }
    __syncthreads();
}

constexpr int AT_KROW = 144, AT_VROW = 136, AT_KBYTES = 2 * 64 * AT_KROW, AT_VBYTES = 128 * AT_VROW, AT_BUF = AT_KBYTES + AT_VBYTES;
__device__ __forceinline__ bool attn_unit(Frame& F, int b, int h, int qblk, float lam) {
    const int lane = F.lane, r32 = lane & 31, hh = lane >> 5, wave = F.wave, mj = wave >> 2, rg = wave & 3;
    LAS unsigned char* const L0 = F.lds + RING_OFF;
    LAS float* X = (LAS float*)(F.lds + RING_OFF);
    const bf16* Qb = (const bf16*)(F.ws + WS_Q); const bf16* Kb = (const bf16*)(F.ws + WS_K); const bf16* Vb = (const bf16*)(F.ws + WS_V);
    const int qrow = b * SEQ + qblk * 128 + rg * 32 + r32;
    bf16x8 qr[4];
#pragma unroll
    for (int ds = 0; ds < 4; ++ds) qr[ds] = *(const GAS bf16x8*)(Qb + (size_t)qrow * 512 + (2 * h + mj) * 64 + 16 * ds + 8 * hh);
    const float slope2 = exp2f(-2.0f * (float)(h + 1)) * LOG2E;
    const int qpos = NMETA + qblk * 128 + rg * 32 + r32;
    const float lanebase = slope2 * (float)(4 * hh - qpos);
    float mref = 0.f, l = 0.f, mxall = 0.f; f32x16 o[4];
#pragma unroll
    for (int i = 0; i < 4; ++i)
#pragma unroll
        for (int r = 0; r < 16; ++r) o[i][r] = 0.f;
    const int NT = 1 + 2 * (qblk + 1);
    const int tfirst = (rg >= 2) ? NT - 1 : NT - 2;
    const bf16* kg = Kb + ((size_t)b * KVROWS + lane) * 512 + (2 * h) * 64 + wave * 8;
    const bf16* vg = Vb + ((size_t)b * KVROWS + lane) * 512 + h * 128 + wave * 8;
    v4u gk0, gk1, gv0, gv1;
#define AT_ISSUE(t) do { const size_t off_ = (size_t)(t) * 64 * 512; gk0 = *(const GAS v4u*)(kg + off_); gk1 = *(const GAS v4u*)(kg + off_ + 64); gv0 = *(const GAS v4u*)(vg + off_); gv1 = *(const GAS v4u*)(vg + off_ + 64); } while (0)
#define AT_COMMIT(buf) do { LAS unsigned char* B_ = L0 + (buf) * AT_BUF; \
        *(LAS v4u*)(B_ + lane * AT_KROW + wave * 16) = gk0; *(LAS v4u*)(B_ + (64 + lane) * AT_KROW + wave * 16) = gk1; \
        LAS unsigned char* V_ = B_ + AT_KBYTES + lane * 2; \
        _Pragma("unroll") for (int e = 0; e < 8; ++e) { *(LAS unsigned short*)(V_ + (8 * wave + e) * AT_VROW) = (unsigned short)((gv0[e >> 1] >> (16 * (e & 1))) & 0xffffu); \
                                                        *(LAS unsigned short*)(V_ + (64 + 8 * wave + e) * AT_VROW) = (unsigned short)((gv1[e >> 1] >> (16 * (e & 1))) & 0xffffu); } } while (0)
#define AT_LOADV(dst, db) do { const LAS unsigned char* vp_ = Bc + AT_KBYTES + (32 * (db) + r32) * AT_VROW + 8 * hh; \
        _Pragma("unroll") for (int ks = 0; ks < 4; ++ks) { const u32x2 lo_ = *(const LAS u32x2*)(vp_ + 32 * ks), hi_ = *(const LAS u32x2*)(vp_ + 32 * ks + 16); dst[ks] = (v4u){lo_.x, lo_.y, hi_.x, hi_.y}; } } while (0)
#define AT_PV(src, db) do { _Pragma("unroll") for (int ks = 0; ks < 4; ++ks) o[db] = __builtin_amdgcn_mfma_f32_32x32x16_bf16(__builtin_bit_cast(bf16x8, src[ks]), pf[ks], o[db], 0, 0, 0); } while (0)
    __syncthreads();
    AT_ISSUE(NT - 1); AT_COMMIT((NT - 1) & 1); AT_ISSUE(NT - 2);
    __syncthreads();
    for (int t = NT - 1; t >= 0; --t) {
        if (t >= 1) AT_COMMIT((t - 1) & 1);
        if (t >= 2) AT_ISSUE(t - 2);
        if (t <= tfirst) {
            const LAS unsigned char* Bc = L0 + (t & 1) * AT_BUF;
            const int kb_pos = (t == 0) ? 0 : NMETA + 64 * (t - 1);
            f32x16 p0, p1;
            { const float sc = slope2 * (float)kb_pos + lanebase - mref;
#pragma unroll
              for (int r = 0; r < 16; ++r) { p0[r] = fmaf(slope2, (float)((r & 3) + 8 * (r >> 2)), sc); p1[r] = p0[r] + 32.0f * slope2; } }
            {   const LAS unsigned char* kp = Bc + (mj * 64 + r32) * AT_KROW + hh * 16;
#pragma unroll
                for (int ds = 0; ds < 4; ++ds) { const bf16x8 a0 = *(const LAS bf16x8*)(kp + ds * 32), a1 = *(const LAS bf16x8*)(kp + 32 * AT_KROW + ds * 32);
                    p0 = __builtin_amdgcn_mfma_f32_32x32x16_bf16(a0, qr[ds], p0, 0, 0, 0); p1 = __builtin_amdgcn_mfma_f32_32x32x16_bf16(a1, qr[ds], p1, 0, 0, 0); } }
            v4u va[4], vb[4];
            AT_LOADV(va, 0);
            if (t == 0) {
#pragma unroll
                for (int r = 0; r < 16; ++r) { if (r >= 8) p0[r] = -INFINITY; p1[r] = -INFINITY; }
            } else if (t >= NT - 2) {
#pragma unroll
                for (int r = 0; r < 16; ++r) { const int kp0 = kb_pos + crow(r, hh); if (kp0 > qpos) p0[r] = -INFINITY; if (kp0 + 32 > qpos) p1[r] = -INFINITY; }
            }
            float mx = fmaxf(p0[0], p1[0]);
#pragma unroll
            for (int r = 1; r < 16; ++r) mx = fmaxf(mx, fmaxf(p0[r], p1[r]));
            mx = fmaxf(mx, __shfl_xor(mx, 32));
            if (t == tfirst) { mref = mx;
#pragma unroll
                for (int r = 0; r < 16; ++r) { p0[r] -= mx; p1[r] -= mx; }
            } else mxall = fmaxf(mxall, mx);
            float rs = 0.f;
#pragma unroll
            for (int r = 0; r < 16; ++r) { p0[r] = ex2(p0[r]); p1[r] = ex2(p1[r]); rs += p0[r] + p1[r]; }
            l += rs;
            bf16x8 pf[4];
            { v4u w; w.x = cvtpk(p0[0], p0[1]); w.y = cvtpk(p0[2], p0[3]); w.z = cvtpk(p0[4], p0[5]); w.w = cvtpk(p0[6], p0[7]); pf[0] = __builtin_bit_cast(bf16x8, w);
              w.x = cvtpk(p0[8], p0[9]); w.y = cvtpk(p0[10], p0[11]); w.z = cvtpk(p0[12], p0[13]); w.w = cvtpk(p0[14], p0[15]); pf[1] = __builtin_bit_cast(bf16x8, w);
              w.x = cvtpk(p1[0], p1[1]); w.y = cvtpk(p1[2], p1[3]); w.z = cvtpk(p1[4], p1[5]); w.w = cvtpk(p1[6], p1[7]); pf[2] = __builtin_bit_cast(bf16x8, w);
              w.x = cvtpk(p1[8], p1[9]); w.y = cvtpk(p1[10], p1[11]); w.z = cvtpk(p1[12], p1[13]); w.w = cvtpk(p1[14], p1[15]); pf[3] = __builtin_bit_cast(bf16x8, w); }
#define SB_ __builtin_amdgcn_sched_barrier(0)
            SB_; AT_LOADV(vb, 1); SB_; AT_PV(va, 0); SB_; AT_LOADV(va, 2); SB_; AT_PV(vb, 1); SB_; AT_LOADV(vb, 3); SB_; AT_PV(va, 2); SB_; AT_PV(vb, 3); SB_;
#undef SB_
        }
        __syncthreads();
    }
#undef AT_ISSUE
#undef AT_COMMIT
#undef AT_LOADV
#undef AT_PV
    l += __shfl_xor(l, 32);
    const float inv = 1.0f / l;
    if (mj == 1) { const float sc = lam * inv;
#pragma unroll
        for (int db = 0; db < 4; ++db)
#pragma unroll
            for (int r = 0; r < 16; ++r) X[((rg * 64) + db * 16 + r) * 64 + lane] = o[db][r] * sc; }
    const bool bad = __syncthreads_or(mxall > 64.0f) != 0;
    if (mj == 0) { float ss = 0.f;
#pragma unroll
        for (int db = 0; db < 4; ++db)
#pragma unroll
            for (int r = 0; r < 16; ++r) { const float d = o[db][r] * inv - X[((rg * 64) + db * 16 + r) * 64 + lane]; o[db][r] = d; ss += d * d; }
        ss += __shfl_xor(ss, 32);
        const float rr = (1.0f / sqrtf(ss * (1.f / 128.f) + EPS)) * (1.0f - LAMBDA_INIT);
        bf16* MIX = (bf16*)(F.ws + WS_MIX) + (size_t)qrow * D + h * 128;
#pragma unroll
        for (int db = 0; db < 4; ++db)
#pragma unroll
            for (int g = 0; g < 4; ++g) { const int dv0 = 32 * db + 8 * g + 4 * hh; const f32x4 sw = *(const GAS f32x4*)(F.in[14] + dv0);
                u32x2 w; w.x = cvtpk(o[db][4 * g] * rr * sw.x, o[db][4 * g + 1] * rr * sw.y); w.y = cvtpk(o[db][4 * g + 2] * rr * sw.z, o[db][4 * g + 3] * rr * sw.w);
                *(GAS u32x2*)(MIX + dv0) = w; } }
    __syncthreads();
    return bad;
}

__device__ __forceinline__ void dec_attn_unit(Frame& F, int d, int sp) {
    const int lane = F.lane, wave = F.wave;
    const float* dcs = (const float*)(F.ws + WS_DEC);
    const GAS f32x4* qp = (const GAS f32x4*)(dcs + DC_Q + (size_t)d * 512 + 8 * lane);
    const f32x4 q0 = qp[0], q1 = qp[1];
    const int h = lane >> 4; const bool odd = (lane >> 3) & 1;
    const float slope2 = exp2f(-2.0f * (float)(h + 1)) * LOG2E;
    const int pidx = sp * 8 + wave; const int page = ((const int*)F.in[5])[d * NPAGES + pidx];
    const float* kp = F.in[2] + (size_t)page * (PAGE * 512) + 8 * lane; const float* vp = F.in[3] + (size_t)page * (PAGE * 512) + 8 * lane;
    float m = -INFINITY, l = 0.f, a0[8], a1[8];
#pragma unroll
    for (int e = 0; e < 8; ++e) { a0[e] = 0.f; a1[e] = 0.f; }
    for (int t0 = 0; t0 < PAGE; t0 += 4) {
        f32x4 k[4][2], v[4][2];
#pragma unroll
        for (int i = 0; i < 4; ++i) { const GAS f32x4* kr = (const GAS f32x4*)(kp + (size_t)(t0 + i) * 512); k[i][0] = kr[0]; k[i][1] = kr[1];
            const GAS f32x4* vr = (const GAS f32x4*)(vp + (size_t)(t0 + i) * 512); v[i][0] = vr[0]; v[i][1] = vr[1]; }
        float s[4]; float mb = -INFINITY;
#pragma unroll
        for (int i = 0; i < 4; ++i) { float pt = (k[i][0].x * q0.x + k[i][0].y * q0.y) + (k[i][0].z * q0.z + k[i][0].w * q0.w) + (k[i][1].x * q1.x + k[i][1].y * q1.y) + (k[i][1].z * q1.z + k[i][1].w * q1.w);
            pt += __shfl_xor(pt, 1); pt += __shfl_xor(pt, 2); pt += __shfl_xor(pt, 4);
            s[i] = pt - slope2 * (float)(PAST - (pidx * PAGE + t0 + i)); mb = fmaxf(mb, s[i]); }
        const float mn = fmaxf(m, mb), alpha = ex2(m - mn); m = mn;
        float p[4], rs = 0.f;
#pragma unroll
        for (int i = 0; i < 4; ++i) { p[i] = ex2(s[i] - mn); rs += p[i]; }
        l = l * alpha + rs;
        const float alpha_o = __shfl_xor(alpha, 8);
        const float al0 = odd ? alpha_o : alpha, al1 = odd ? alpha : alpha_o;
#pragma unroll
        for (int e = 0; e < 8; ++e) { a0[e] *= al0; a1[e] *= al1; }
#pragma unroll
        for (int i = 0; i < 4; ++i) { const float po = __shfl_xor(p[i], 8); const float pj0 = odd ? po : p[i], pj1 = odd ? p[i] : po;
            a0[0] += pj0 * v[i][0].x; a0[1] += pj0 * v[i][0].y; a0[2] += pj0 * v[i][0].z; a0[3] += pj0 * v[i][0].w; a0[4] += pj0 * v[i][1].x; a0[5] += pj0 * v[i][1].y; a0[6] += pj0 * v[i][1].z; a0[7] += pj0 * v[i][1].w;
            a1[0] += pj1 * v[i][0].x; a1[1] += pj1 * v[i][0].y; a1[2] += pj1 * v[i][0].z; a1[3] += pj1 * v[i][0].w; a1[4] += pj1 * v[i][1].x; a1[5] += pj1 * v[i][1].y; a1[6] += pj1 * v[i][1].z; a1[7] += pj1 * v[i][1].w; }
    }
    LAS float* Rml = (LAS float*)(F.lds + RING_OFF);
    LAS float* Racc = Rml + 128;
    if ((lane & 7) == 0) { Rml[wave * 16 + (lane >> 3)] = m; Rml[wave * 16 + 8 + (lane >> 3)] = l; }
#pragma unroll
    for (int e = 0; e < 8; ++e) { Racc[(wave * 16 + e) * 64 + lane] = a0[e]; Racc[(wave * 16 + 8 + e) * 64 + lane] = a1[e]; }
    __syncthreads();
    if (wave == 0) {
        float* part = (float*)(F.ws + WS_DEC) + DC_PART + ((size_t)(d * NSPLIT + sp) * 8) * 132;
#pragma unroll
        for (int j = 0; j < 2; ++j) { const int hj = 2 * h + j; float M = -INFINITY;
#pragma unroll
            for (int w = 0; w < 8; ++w) M = fmaxf(M, Rml[w * 16 + hj]);
            float L = 0.f, acc[8];
#pragma unroll
            for (int e = 0; e < 8; ++e) acc[e] = 0.f;
#pragma unroll
            for (int w = 0; w < 8; ++w) { const float f = ex2(Rml[w * 16 + hj] - M); L += Rml[w * 16 + 8 + hj] * f;
#pragma unroll
                for (int e = 0; e < 8; ++e) acc[e] += Racc[(w * 16 + 8 * j + e) * 64 + lane] * f; }
            float* o = part + (size_t)hj * 132 + 8 * (lane & 15);
            *(f32x4*)o = (f32x4){acc[0], acc[1], acc[2], acc[3]}; *(f32x4*)(o + 4) = (f32x4){acc[4], acc[5], acc[6], acc[7]};
            if ((lane & 15) == 0) { part[(size_t)hj * 132 + 128] = M; part[(size_t)hj * 132 + 129] = L; } }
    }
    __syncthreads();
}

__device__ __forceinline__ void dec_combine(Frame& F, int d, float lam) {
    const int lane = F.lane, wave = F.wave;
    float* dcs = (float*)(F.ws + WS_DEC);
    LAS float* ybuf = (LAS float*)(F.lds + RING_OFF);
    if (wave < 4) {
        const int h = wave; float od[2][2];
#pragma unroll
        for (int j = 0; j < 2; ++j) { const int hj = 2 * h + j;
            const float sn = wave_sum(dcs[DC_Q + (size_t)d * 512 + hj * 64 + lane] * F.out[O_KS + (size_t)d * 512 + hj * 64 + lane]);
            const float* part = dcs + DC_PART + ((size_t)d * NSPLIT * 8 + hj) * 132;
            float M = sn;
#pragma unroll
            for (int s = 0; s < NSPLIT; ++s) M = fmaxf(M, part[(size_t)s * 8 * 132 + 128]);
            const float fn = ex2(sn - M); float L = fn;
            float a0 = fn * F.out[O_VS + (size_t)d * 512 + h * 128 + 2 * lane], a1 = fn * F.out[O_VS + (size_t)d * 512 + h * 128 + 2 * lane + 1];
#pragma unroll
            for (int s = 0; s < NSPLIT; ++s) { const float* ps = part + (size_t)s * 8 * 132; const float f = ex2(ps[128] - M); L += ps[129] * f; a0 += ps[2 * lane] * f; a1 += ps[2 * lane + 1] * f; }
            od[j][0] = a0 / L; od[j][1] = a1 / L; }
        const float d0 = od[0][0] - lam * od[1][0], d1 = od[0][1] - lam * od[1][1];
        const float ss = wave_sum(d0 * d0 + d1 * d1);
        const float rr = (1.0f / sqrtf(ss * (1.f / 128.f) + EPS)) * (1.0f - LAMBDA_INIT);
        dcs[DC_MIX + (size_t)d * D + h * 128 + 2 * lane] = d0 * rr * F.in[14][2 * lane]; dcs[DC_MIX + (size_t)d * D + h * 128 + 2 * lane + 1] = d1 * rr * F.in[14][2 * lane + 1];
    } else {
#pragma unroll
        for (int k = 0; k < 2; ++k) { const int ch = (wave - 4) * 128 + k * 64 + lane; float a = F.in[16][ch];
            for (int w = 0; w < CW - 1; ++w) a += F.in[4][((size_t)d * 30 + w) * 512 + ch] * F.in[15][w * 512 + ch];
            a += F.out[O_CS + ((size_t)d * 30 + 29) * 512 + ch] * F.in[15][(CW - 1) * 512 + ch];
            ybuf[ch] = a; }
    }
    __syncthreads();
    if (wave >= 4) { float s1 = 0.f, s2 = 0.f;
#pragma unroll
        for (int i = 0; i < 8; ++i) { const float y = ybuf[i * 64 + lane]; s1 += y; s2 += y * y; }
        s1 = wave_sum(s1); s2 = wave_sum(s2);
        const float mean = s1 * (1.f / 512.f), var = s2 * (1.f / 512.f) - mean * mean, rstd = 1.0f / sqrtf(var + EPS);
#pragma unroll
        for (int k = 0; k < 2; ++k) { const int ch = (wave - 4) * 128 + k * 64 + lane; float v = (ybuf[ch] - mean) * rstd * F.in[17][ch] + F.in[18][ch]; v = v * sigm(v); dcs[DC_MIX + (size_t)d * D + 512 + ch] = v; }
    }
    __syncthreads();
}

template <int NC> __device__ __forceinline__ void dec_dot(const float* A, int lda, int K, const bf16* const (&w)[NC], float (&res)[4][NC], int wave, int lane) {
    float acc[4][NC];
#pragma unroll
    for (int r = 0; r < 4; ++r)
#pragma unroll
        for (int n = 0; n < NC; ++n) acc[r][n] = 0.f;
    for (int c = lane; c < K / 8; c += 64) {
        f32x4 a[4][2];
#pragma unroll
        for (int r = 0; r < 4; ++r) { const GAS f32x4* ap = (const GAS f32x4*)(A + (size_t)(4 * wave + r) * lda + 8 * c); a[r][0] = ap[0]; a[r][1] = ap[1]; }
#pragma unroll
        for (int n = 0; n < NC; ++n) { const v4u wv = *(const GAS v4u*)(w[n] + 8 * c); float wf[8];
#pragma unroll
            for (int e = 0; e < 4; ++e) { wf[2 * e] = __uint_as_float(wv[e] << 16); wf[2 * e + 1] = __uint_as_float(wv[e] & 0xffff0000u); }
#pragma unroll
            for (int r = 0; r < 4; ++r) acc[r][n] += (a[r][0].x * wf[0] + a[r][0].y * wf[1]) + (a[r][0].z * wf[2] + a[r][0].w * wf[3]) + (a[r][1].x * wf[4] + a[r][1].y * wf[5]) + (a[r][1].z * wf[6] + a[r][1].w * wf[7]); }
    }
#pragma unroll
    for (int r = 0; r < 4; ++r)
#pragma unroll
        for (int n = 0; n < NC; ++n) res[r][n] = wave_sum(acc[r][n]);
}
__device__ __forceinline__ void dec_norm1_row(Frame& F, int d) {
    float* dcs = (float*)(F.ws + WS_DEC); const int lane = F.lane;
    f32x4 mo[4], x[4]; float s = 0.f;
#pragma unroll
    for (int j = 0; j < 4; ++j) { mo[j] = *(const GAS f32x4*)(dcs + DC_MIXOUT + (size_t)d * D + 4 * lane + 256 * j); s += (mo[j].x * mo[j].x + mo[j].y * mo[j].y) + (mo[j].z * mo[j].z + mo[j].w * mo[j].w); }
    const float r = 1.0f / sqrtf(wave_sum(s) * (1.f / D) + EPS); float s2 = 0.f;
#pragma unroll
    for (int j = 0; j < 4; ++j) { const f32x4 g = *(const GAS f32x4*)(F.in[8] + 4 * lane + 256 * j); x[j] = *(const GAS f32x4*)(F.in[1] + (size_t)d * D + 4 * lane + 256 * j) + mo[j] * r * g;
        s2 += (x[j].x * x[j].x + x[j].y * x[j].y) + (x[j].z * x[j].z + x[j].w * x[j].w); *(GAS f32x4*)(dcs + DC_X1 + (size_t)d * D + 4 * lane + 256 * j) = x[j]; }
    const float r2 = 1.0f / sqrtf(wave_sum(s2) * (1.f / D) + EPS);
#pragma unroll
    for (int j = 0; j < 4; ++j) { const f32x4 g = *(const GAS f32x4*)(F.in[20] + 4 * lane + 256 * j); *(GAS f32x4*)(dcs + DC_H + (size_t)d * D + 4 * lane + 256 * j) = x[j] * r2 * g; }
}
__device__ __forceinline__ void dec_norm2_row(Frame& F, int d) {
    float* dcs = (float*)(F.ws + WS_DEC); const int lane = F.lane;
    f32x4 f[4]; float s = 0.f;
#pragma unroll
    for (int j = 0; j < 4; ++j) { f[j] = *(const GAS f32x4*)(dcs + DC_F + (size_t)d * D + 4 * lane + 256 * j); s += (f[j].x * f[j].x + f[j].y * f[j].y) + (f[j].z * f[j].z + f[j].w * f[j].w); }
    const float r = 1.0f / sqrtf(wave_sum(s) * (1.f / D) + EPS);
#pragma unroll
    for (int j = 0; j < 4; ++j) { const f32x4 g = *(const GAS f32x4*)(F.in[21] + 4 * lane + 256 * j);
        *(GAS f32x4*)(F.out + O_YS + (size_t)d * D + 4 * lane + 256 * j) = *(const GAS f32x4*)(dcs + DC_X1 + (size_t)d * D + 4 * lane + 256 * j) + f[j] * r * g; }
}
__device__ __forceinline__ void norm1_row(Frame& F, int row) {
    const int lane = F.lane; const float* mo_ = (const float*)(F.ws + WS_MIXOUT) + (size_t)row * D; float* x1_ = (float*)(F.ws + WS_X1) + (size_t)row * D; bf16* hn = (bf16*)(F.ws + WS_HN) + (size_t)row * D;
    f32x4 mo[4], x[4]; float s = 0.f;
#pragma unroll
    for (int j = 0; j < 4; ++j) { mo[j] = *(const GAS f32x4*)(mo_ + 4 * lane + 256 * j); s += (mo[j].x * mo[j].x + mo[j].y * mo[j].y) + (mo[j].z * mo[j].z + mo[j].w * mo[j].w); }
    const float r = 1.0f / sqrtf(wave_sum(s) * (1.f / D) + EPS); float s2 = 0.f;
#pragma unroll
    for (int j = 0; j < 4; ++j) { const f32x4 g = *(const GAS f32x4*)(F.in[8] + 4 * lane + 256 * j); x[j] = *(const GAS f32x4*)(F.in[0] + (size_t)row * D + 4 * lane + 256 * j) + mo[j] * r * g;
        s2 += (x[j].x * x[j].x + x[j].y * x[j].y) + (x[j].z * x[j].z + x[j].w * x[j].w); *(GAS f32x4*)(x1_ + 4 * lane + 256 * j) = x[j]; }
    const float r2 = 1.0f / sqrtf(wave_sum(s2) * (1.f / D) + EPS);
#pragma unroll
    for (int j = 0; j < 4; ++j) { const f32x4 g = *(const GAS f32x4*)(F.in[20] + 4 * lane + 256 * j); const f32x4 hv = x[j] * r2 * g;
        *(GAS u32x2*)(hn + 4 * lane + 256 * j) = (u32x2){pk2(hv.x, hv.y), pk2(hv.z, hv.w)}; }
}
__device__ __forceinline__ void norm2_row(Frame& F, int row) {
    const int lane = F.lane; const float* f_ = (const float*)(F.ws + WS_MIXOUT) + (size_t)row * D; const float* x1_ = (const float*)(F.ws + WS_X1) + (size_t)row * D;
    f32x4 f[4]; float s = 0.f;
#pragma unroll
    for (int j = 0; j < 4; ++j) { f[j] = *(const GAS f32x4*)(f_ + 4 * lane + 256 * j); s += (f[j].x * f[j].x + f[j].y * f[j].y) + (f[j].z * f[j].z + f[j].w * f[j].w); }
    const float r = 1.0f / sqrtf(wave_sum(s) * (1.f / D) + EPS);
#pragma unroll
    for (int j = 0; j < 4; ++j) { const f32x4 g = *(const GAS f32x4*)(F.in[21] + 4 * lane + 256 * j);
        *(GAS f32x4*)(F.out + O_YP + (size_t)row * D + 4 * lane + 256 * j) = *(const GAS f32x4*)(x1_ + 4 * lane + 256 * j) + f[j] * r * g; }
}
constexpr int PER_PHASE = 9;
#ifndef MK_N_LAUNCHES
#define MK_N_LAUNCHES 1
#endif
constexpr int N_LAUNCHES = MK_N_LAUNCHES;
struct Args { const float* in[25]; float* out; unsigned char* ws; int ph_lo, ph_hi; };
__global__ void __launch_bounds__(NWAVES * 64, 2) hymba_fwd(Args args) {
    extern __shared__ __attribute__((aligned(16))) unsigned char lds[];
    Frame F;
    F.lds = (LAS unsigned char*)lds;
    F.MISC = (volatile LAS unsigned*)(F.lds + MISC_OFF);
    F.tid = threadIdx.x; F.lane = F.tid & 63; F.wave = __builtin_amdgcn_readfirstlane(F.tid >> 6);
    F.G = gridDim.x; { const int bx = blockIdx.x; F.vcu = (F.G % 8 == 0) ? (bx % 8) * (F.G / 8) + bx / 8 : bx; }
#pragma unroll
    for (int i = 0; i < 25; ++i) F.in[i] = args.in[i];
    F.out = args.out; F.ws = args.ws;
    F.ctl = (gu32*)(args.ws + WS_CTL);
    for (int u = F.tid; u < (LDS_BYTES - LDSCTL_OFF) / 4; u += NWAVES * 64) ((LAS unsigned*)(F.lds + LDSCTL_OFF))[u] = 0u;
    __syncthreads();
    XcdBarrier bar; bar.bar = (unsigned*)(F.ctl + CW_BAR); bar.x = 0; bar.st = nullptr;
    if (N_LAUNCHES == 1) bar = xcd_barrier_post((unsigned*)(F.ctl + CW_BAR), F.MISC + 8);
#define GRID_BAR() do { if (N_LAUNCHES == 1) xcd_barrier(bar); } while (0)
    const int lo = args.ph_lo, hi = args.ph_hi;
#define IN(k) (lo <= (k) && (k) < hi)
#define BOTH(k) (IN(k) && IN((k) + 1))
    float* dcs = (float*)(F.ws + WS_DEC);
    const int gw = F.vcu * NWAVES + F.wave, NGW = F.G * NWAVES;

    if (IN(0)) { p0_prologue(F); if (BOTH(0)) GRID_BAR(); }

    if (IN(1)) {
        pg8::Gemm g{(const bf16*)(F.ws + WS_XN), (const bf16*)(F.ws + WS_WIN), M_PAD, INC, D}; pg8::StaticOrder S; S.init(M_PAD, INC, F.G, (int)blockIdx.x);
        pg8::EpiIn E{(bf16*)(F.ws + WS_Q), (bf16*)(F.ws + WS_K), (bf16*)(F.ws + WS_V), (bf16*)(F.ws + WS_U), F.out, dcs + DC_Q};
        pg8::gemm_phase<pg8::EpiIn, pg8::StaticOrder, true, true>(F.lds + RING_OFF, g, S, E);
        if (BOTH(1)) GRID_BAR();
    }

    if (IN(2)) {
        const float lam = diff_lambda(F);
        for (int p = F.vcu; p < NB * NH * 8; p += F.G) {
            const int b = p >> 5, h = (p >> 3) & 3, a = p & 7;
            for (int k = 0; k < 2; ++k) { const int qb = k ? a : 15 - a; if (attn_unit(F, b, h, qb, lam)) attn_unit_slow(F, b, h, qb, lam); }
        }
        for (int t = F.vcu; t < M_REAL / 64; t += F.G) conv_tile(F, t >> 5, (t & 31) * 64);
        for (int u = F.vcu; u < DB * NSPLIT; u += F.G) dec_attn_unit(F, u >> 3, u & 7);
        if (BOTH(2)) GRID_BAR();
    }

    if (IN(3)) {
        if (F.vcu < DB) { const float lam = diff_lambda(F); dec_combine(F, F.vcu, lam); }
        pg8::Gemm g{(const bf16*)(F.ws + WS_MIX), (const bf16*)(F.ws + WS_WO), M_REAL, D, D}; pg8::StaticOrder S; S.init(M_REAL, D, F.G, (int)blockIdx.x);
        pg8::EpiF32 E{(float*)(F.ws + WS_MIXOUT), D};
        pg8::gemm_phase<pg8::EpiF32, pg8::StaticOrder, true, true>(F.lds + RING_OFF, g, S, E);
        if (BOTH(3)) GRID_BAR();
    }

    if (IN(4)) {
        for (int c0 = 4 * F.vcu; c0 < D; c0 += 4 * F.G) {
            const bf16* Wo_t = (const bf16*)(F.ws + WS_WO); const bf16* const w[4] = {Wo_t + (size_t)c0 * D, Wo_t + (size_t)(c0 + 1) * D, Wo_t + (size_t)(c0 + 2) * D, Wo_t + (size_t)(c0 + 3) * D};
            float res[4][4]; dec_dot<4>(dcs + DC_MIX, D, D, w, res, F.wave, F.lane);
            if (F.lane == 0) {
#pragma unroll
                for (int r = 0; r < 4; ++r)
#pragma unroll
                    for (int n = 0; n < 4; ++n) dcs[DC_MIXOUT + (size_t)(4 * F.wave + r) * D + c0 + n] = res[r][n]; }
        }
        for (int m = gw; m < M_REAL; m += NGW) norm1_row(F, m);
        if (BOTH(4)) GRID_BAR();
    }

    if (IN(5)) {
        if (F.vcu < DB && F.wave == 0) dec_norm1_row(F, F.vcu);
        pg8::Gemm g{(const bf16*)(F.ws + WS_HN), (const bf16*)(F.ws + WS_WGU), M_REAL, 2 * FF, D}; pg8::StaticOrder S; S.init(M_REAL, 2 * FF, F.G, (int)blockIdx.x);
        pg8::EpiSwiGLU E{(bf16*)(F.ws + WS_ACT)};
        pg8::gemm_phase<pg8::EpiSwiGLU, pg8::StaticOrder, true, true>(F.lds + RING_OFF, g, S, E);
        if (BOTH(5)) GRID_BAR();
    }

    if (IN(6)) {
        for (int ch0 = 11 * F.vcu; ch0 < FF; ch0 += 11 * F.G) {
            for (int i = 0; i < 11; ++i) { const int ch = ch0 + i; const bf16* wg = (const bf16*)(F.ws + WS_WGU) + (size_t)(256 * (ch >> 7) + (ch & 127)) * D; const bf16* const w[2] = {wg, wg + (size_t)128 * D};
                float res[4][2]; dec_dot<2>(dcs + DC_H, D, D, w, res, F.wave, F.lane);
                if (F.lane == 0) {
#pragma unroll
                    for (int r = 0; r < 4; ++r) dcs[DC_ACT + (size_t)(4 * F.wave + r) * FF + ch] = res[r][0] * sigm(res[r][0]) * res[r][1]; } }
        }
        pg8::Gemm g{(const bf16*)(F.ws + WS_ACT), (const bf16*)(F.ws + WS_WD), M_REAL, D, FF}; pg8::StaticOrder S; S.init(M_REAL, D, F.G, (int)blockIdx.x);
        pg8::EpiF32 E{(float*)(F.ws + WS_MIXOUT), D};
        pg8::gemm_phase<pg8::EpiF32, pg8::StaticOrder, true, true>(F.lds + RING_OFF, g, S, E);
        if (BOTH(6)) GRID_BAR();
    }

    if (IN(7)) {
        for (int c0 = 4 * F.vcu; c0 < D; c0 += 4 * F.G) {
            const bf16* Wd_t = (const bf16*)(F.ws + WS_WD); const bf16* const w[4] = {Wd_t + (size_t)c0 * FF, Wd_t + (size_t)(c0 + 1) * FF, Wd_t + (size_t)(c0 + 2) * FF, Wd_t + (size_t)(c0 + 3) * FF};
            float res[4][4]; dec_dot<4>(dcs + DC_ACT, FF, FF, w, res, F.wave, F.lane);
            if (F.lane == 0) {
#pragma unroll
                for (int r = 0; r < 4; ++r)
#pragma unroll
                    for (int n = 0; n < 4; ++n) dcs[DC_F + (size_t)(4 * F.wave + r) * D + c0 + n] = res[r][n]; }
        }
        for (int m = gw; m < M_REAL; m += NGW) norm2_row(F, m);
        if (BOTH(7)) GRID_BAR();
    }

    if (IN(8)) { if (F.vcu < DB && F.wave == 0) dec_norm2_row(F, F.vcu); }
#undef IN
#undef BOTH
}

extern "C" void kernel_launch(void* const* d_in, const int* in_sizes, int n_in, void* d_out, int out_size, void* d_ws, size_t ws_size, hipStream_t stream) {
    static int grid = 0;
    if (grid == 0) {
        if (n_in != 25 || out_size != (int)O_END || ws_size < WS_END) { fprintf(stderr, "kernel_launch: unexpected shapes (n_in %d out %d ws %zu)\n", n_in, out_size, ws_size); grid = -1; return; }
        int dev = 0, cus = 0, per_cu = 0;
        if (hipGetDevice(&dev) != hipSuccess || hipDeviceGetAttribute(&cus, hipDeviceAttributeMultiprocessorCount, dev) != hipSuccess) { grid = -1; return; }
        if (hipFuncSetAttribute((const void*)hymba_fwd, hipFuncAttributeMaxDynamicSharedMemorySize, LDS_BYTES) != hipSuccess) { fprintf(stderr, "kernel_launch: hipFuncSetAttribute failed\n"); grid = -1; return; }
        if (hipOccupancyMaxActiveBlocksPerMultiprocessor(&per_cu, (const void*)hymba_fwd, NWAVES * 64, LDS_BYTES) != hipSuccess || per_cu < 1)
            fprintf(stderr, "kernel_launch: note: occupancy query reports %d workgroups per CU\n", per_cu);
        (void)hipGetLastError();
        grid = cus;
    }
    if (grid < 0) return;
    if (hipMemsetAsync((char*)d_ws + WS_CTL, 0, CTL_ZERO_BYTES, stream) != hipSuccess) return;
    Args a{};
    for (int i = 0; i < 25; ++i) a.in[i] = (const float*)d_in[i];
    a.out = (float*)d_out; a.ws = (unsigned char*)d_ws;
    if (N_LAUNCHES == 1) { a.ph_lo = 0; a.ph_hi = PER_PHASE; hipLaunchKernelGGL(hymba_fwd, dim3(grid), dim3(NWAVES * 64), LDS_BYTES, stream, a); }
    else for (int li = 0; li < PER_PHASE; ++li) { a.ph_lo = li; a.ph_hi = li + 1; hipLaunchKernelGGL(hymba_fwd, dim3(grid), dim3(NWAVES * 64), LDS_BYTES, stream, a); }
}
```
